# Optimizing an MI355X kernel written in HIP

```python
import jax, jax.numpy as jnp
from jax import lax
import numpy as np

D_MODEL = 1024
BATCH = 8
SEQ = 2048
DEPTH = 1
DEC_BATCH = 128
DEC_SEQ = 4
PAST_LEN = 16384
PAGE_SIZE = 128

D_MIX = D_MODEL
D_CONV = D_MIX // 2
D_LRU = D_MIX - D_CONV
CONV_GROUPS = 8
LRU_HEADS = 8
LRU_HEAD_DIM = D_LRU // LRU_HEADS
CONV_WIDTH = 31
LRU_CONV_WIDTH = 4
LRU_C = 8.0
D_FF = 2816
D_PLE = 256
D_IN = 2 * D_CONV + 2 * D_LRU
EPS = 1e-6
FFN_RES_WEIGHT = 0.5

kernel_name = "hymba_conformer_rglru_macaron_step"


def rmsnorm(x, g):
    xf = x.astype(jnp.float32)
    y = xf * lax.rsqrt(jnp.mean(xf * xf, axis=-1, keepdims=True) + EPS)
    return (y * g.astype(jnp.float32)).astype(x.dtype)


def swiglu_ffn(x, w_gu, w_down):
    gu = x @ w_gu
    gate, up = jnp.split(gu, 2, axis=-1)
    return (jax.nn.silu(gate) * up) @ w_down


def causal_dwconv(xp, w, b):
    c = xp.shape[-1]
    y = lax.conv_general_dilated(xp, w[:, None, :].astype(xp.dtype), window_strides=(1,),
                                 padding='VALID', dimension_numbers=('NWC', 'WIO', 'NWC'),
                                 feature_group_count=c)
    return y + b


def lru_combine(left, right):
    a_l, b_l = left
    a_r, b_r = right
    return a_l * a_r, a_r * b_l + b_r


def mixer_block(x, conv_buf, lconv_buf, h0, pre_g, post_g, w_in, conv_w, conv_b, conv_norm_g,
                lru_conv_w, lru_conv_b, lru_wa, lru_ba, lru_wx, lru_bx, lru_lambda, w_out):
    bsz, t, _ = x.shape
    h = rmsnorm(x, pre_g)
    u = h @ w_in
    u_val, u_glu, u_x, u_gelu = jnp.split(u, [D_CONV, 2 * D_CONV, 2 * D_CONV + D_LRU], axis=-1)

    g = u_val * jax.nn.sigmoid(u_glu)
    gp = jnp.concatenate([conv_buf.astype(g.dtype), g], axis=1)
    c = causal_dwconv(gp, conv_w, conv_b)
    c = jax.nn.silu(rmsnorm(c, conv_norm_g))
    new_conv_buf = gp[:, -(CONV_WIDTH - 1):, :]

    xp = jnp.concatenate([lconv_buf.astype(u_x.dtype), u_x], axis=1)
    xc = causal_dwconv(xp, lru_conv_w, lru_conv_b)
    new_lconv_buf = xp[:, -(LRU_CONV_WIDTH - 1):, :]
    xh = xc.reshape(bsz, t, LRU_HEADS, LRU_HEAD_DIM)
    r = jax.nn.sigmoid(jnp.einsum('bthi,hij->bthj', xh, lru_wa).reshape(bsz, t, D_LRU) + lru_ba)
    i_g = jax.nn.sigmoid(jnp.einsum('bthi,hij->bthj', xh, lru_wx).reshape(bsz, t, D_LRU) + lru_bx)
    log_a = -LRU_C * r.astype(jnp.float32) * jax.nn.softplus(-lru_lambda.astype(jnp.float32))
    a = jnp.exp(log_a)
    bterm = jnp.sqrt(-jnp.expm1(2.0 * log_a)) * (i_g * xc).astype(jnp.float32)
    bterm = bterm.at[:, 0, :].add(a[:, 0, :] * h0.astype(jnp.float32))
    _, hs = lax.associative_scan(lru_combine, (a, bterm), axis=1)
    h_last = hs[:, -1, :].astype(h0.dtype)
    yb = hs.astype(x.dtype) * jax.nn.gelu(u_gelu)

    out = jnp.concatenate([c, yb], axis=-1) @ w_out
    return x + rmsnorm(out, post_g), new_conv_buf, new_lconv_buf, h_last


def decoder_layer(x, p, conv_buf, lconv_buf, h0, l,
                  ffn1_pre_g, ffn1_post_g, ffn1_w_gu, ffn1_w_down,
                  mix_pre_g, mix_post_g, w_in, conv_w, conv_b, conv_norm_g,
                  lru_conv_w, lru_conv_b, lru_wa, lru_ba, lru_wx, lru_bx, lru_lambda, w_out,
                  ffn2_pre_g, ffn2_post_g, ffn2_w_gu, ffn2_w_down,
                  ple_norm_g, ple_w_gate, ple_w_proj, ple_post_g):
    x = x + FFN_RES_WEIGHT * rmsnorm(swiglu_ffn(rmsnorm(x, ffn1_pre_g[l]), ffn1_w_gu[l], ffn1_w_down[l]),
                                     ffn1_post_g[l])
    x, cb, lcb, hl = mixer_block(x, conv_buf, lconv_buf, h0, mix_pre_g[l], mix_post_g[l], w_in[l],
                                 conv_w[l], conv_b[l], conv_norm_g[l], lru_conv_w[l], lru_conv_b[l],
                                 lru_wa[l], lru_ba[l], lru_wx[l], lru_bx[l], lru_lambda[l], w_out[l])
    x = x + FFN_RES_WEIGHT * rmsnorm(swiglu_ffn(rmsnorm(x, ffn2_pre_g[l]), ffn2_w_gu[l], ffn2_w_down[l]),
                                     ffn2_post_g[l])
    gate = jax.nn.sigmoid(rmsnorm(x, ple_norm_g[l]) @ ple_w_gate[l])
    e = p @ ple_w_proj[l]
    x = x + rmsnorm(gate * e, ple_post_g[l])
    return x, cb, lcb, hl


def setup_inputs(seed: int = 0) -> dict:
    key = jax.random.key(seed)
    ks = iter(jax.random.split(key, 40))
    f32 = jnp.float32

    def nrm(shape, scale):
        return jax.random.normal(next(ks), shape, f32) * scale

    def gain(shape):
        return 1.0 + 0.05 * jax.random.normal(next(ks), shape, f32)

    x_prompt = nrm((BATCH, SEQ, D_MODEL), 1.0)
    x_sample = nrm((DEC_BATCH, DEC_SEQ, D_MODEL), 1.0)
    cache_conv = nrm((DEPTH, DEC_BATCH, CONV_WIDTH - 1, D_CONV), 0.5)
    state_lru_conv = nrm((DEPTH, DEC_BATCH, LRU_CONV_WIDTH - 1, D_LRU), 0.5)
    state_lru_h = nrm((DEPTH, DEC_BATCH, D_LRU), 0.5)
    p_prompt = nrm((DEPTH, BATCH, SEQ, D_PLE), 1.0)
    p_sample = nrm((DEPTH, DEC_BATCH, DEC_SEQ, D_PLE), 1.0)

    u = jax.random.uniform(next(ks), (DEPTH, D_LRU), f32, minval=0.9, maxval=0.999)
    a0 = u ** (1.0 / LRU_C)
    lru_lambda = jnp.log(a0) - jnp.log1p(-a0)

    return {
        "x_prompt": x_prompt, "x_sample": x_sample,
        "cache_conv": cache_conv, "state_lru_conv": state_lru_conv, "state_lru_h": state_lru_h,
        "p_prompt": p_prompt, "p_sample": p_sample,
        "ffn1_pre_g": gain((DEPTH, D_MODEL)), "ffn1_post_g": gain((DEPTH, D_MODEL)),
        "ffn1_w_gu": nrm((DEPTH, D_MODEL, 2 * D_FF), D_MODEL ** -0.5),
        "ffn1_w_down": nrm((DEPTH, D_FF, D_MODEL), D_FF ** -0.5),
        "mix_pre_g": gain((DEPTH, D_MODEL)), "mix_post_g": gain((DEPTH, D_MODEL)),
        "w_in": nrm((DEPTH, D_MODEL, D_IN), D_MODEL ** -0.5),
        "conv_w": nrm((DEPTH, CONV_WIDTH, D_CONV), CONV_WIDTH ** -0.5),
        "conv_b": nrm((DEPTH, D_CONV), 0.01),
        "conv_norm_g": gain((DEPTH, D_CONV)),
        "lru_conv_w": nrm((DEPTH, LRU_CONV_WIDTH, D_LRU), LRU_CONV_WIDTH ** -0.5),
        "lru_conv_b": nrm((DEPTH, D_LRU), 0.01),
        "lru_wa": nrm((DEPTH, LRU_HEADS, LRU_HEAD_DIM, LRU_HEAD_DIM), LRU_HEAD_DIM ** -0.5),
        "lru_ba": nrm((DEPTH, D_LRU), 0.01),
        "lru_wx": nrm((DEPTH, LRU_HEADS, LRU_HEAD_DIM, LRU_HEAD_DIM), LRU_HEAD_DIM ** -0.5),
        "lru_bx": nrm((DEPTH, D_LRU), 0.01),
        "lru_lambda": lru_lambda,
        "w_out": nrm((DEPTH, D_MIX, D_MODEL), D_MIX ** -0.5),
        "ffn2_pre_g": gain((DEPTH, D_MODEL)), "ffn2_post_g": gain((DEPTH, D_MODEL)),
        "ffn2_w_gu": nrm((DEPTH, D_MODEL, 2 * D_FF), D_MODEL ** -0.5),
        "ffn2_w_down": nrm((DEPTH, D_FF, D_MODEL), D_FF ** -0.5),
        "ple_norm_g": gain((DEPTH, D_MODEL)),
        "ple_w_gate": nrm((DEPTH, D_MODEL, D_MODEL), D_MODEL ** -0.5),
        "ple_w_proj": nrm((DEPTH, D_PLE, D_MODEL), D_PLE ** -0.5),
        "ple_post_g": gain((DEPTH, D_MODEL)),
    }


def reference(x_prompt, x_sample, cache_conv, state_lru_conv, state_lru_h, p_prompt, p_sample,
              ffn1_pre_g, ffn1_post_g, ffn1_w_gu, ffn1_w_down,
              mix_pre_g, mix_post_g, w_in, conv_w, conv_b, conv_norm_g,
              lru_conv_w, lru_conv_b, lru_wa, lru_ba, lru_wx, lru_bx, lru_lambda, w_out,
              ffn2_pre_g, ffn2_post_g, ffn2_w_gu, ffn2_w_down,
              ple_norm_g, ple_w_gate, ple_w_proj, ple_post_g):
    dt = x_prompt.dtype
    xp, xs = x_prompt, x_sample
    conv_p, lconv_p, h_p = [], [], []
    conv_s, lconv_s, h_s = [], [], []
    for l in range(DEPTH):
        zc = jnp.zeros((BATCH, CONV_WIDTH - 1, D_CONV), dt)
        zl = jnp.zeros((BATCH, LRU_CONV_WIDTH - 1, D_LRU), dt)
        zh = jnp.zeros((BATCH, D_LRU), state_lru_h.dtype)
        xp, cb, lcb, hl = decoder_layer(
            xp, p_prompt[l], zc, zl, zh, l,
            ffn1_pre_g, ffn1_post_g, ffn1_w_gu, ffn1_w_down,
            mix_pre_g, mix_post_g, w_in, conv_w, conv_b, conv_norm_g,
            lru_conv_w, lru_conv_b, lru_wa, lru_ba, lru_wx, lru_bx, lru_lambda, w_out,
            ffn2_pre_g, ffn2_post_g, ffn2_w_gu, ffn2_w_down,
            ple_norm_g, ple_w_gate, ple_w_proj, ple_post_g)
        conv_p.append(cb); lconv_p.append(lcb); h_p.append(hl)
        xs, cb, lcb, hl = decoder_layer(
            xs, p_sample[l], cache_conv[l], state_lru_conv[l], state_lru_h[l], l,
            ffn1_pre_g, ffn1_post_g, ffn1_w_gu, ffn1_w_down,
            mix_pre_g, mix_post_g, w_in, conv_w, conv_b, conv_norm_g,
            lru_conv_w, lru_conv_b, lru_wa, lru_ba, lru_wx, lru_bx, lru_lambda, w_out,
            ffn2_pre_g, ffn2_post_g, ffn2_w_gu, ffn2_w_down,
            ple_norm_g, ple_w_gate, ple_w_proj, ple_post_g)
        conv_s.append(cb); lconv_s.append(lcb); h_s.append(hl)
    new_conv_p = jnp.stack(conv_p)
    new_lru_conv_p = jnp.stack(lconv_p)
    new_lru_h_p = jnp.stack(h_p)
    new_conv_s = jnp.stack(conv_s)
    new_lru_conv_s = jnp.stack(lconv_s)
    new_lru_h_s = jnp.stack(h_s)
    return (xp, xs, new_conv_p, new_lru_conv_p, new_lru_h_p, new_conv_s, new_lru_conv_s, new_lru_h_s)
```

```cpp
#include <hip/hip_runtime.h>
#include <hip/hip_cooperative_groups.h>
#include <cstdio>
#include <cstdint>
namespace cg = cooperative_groups;
namespace pg8 {
#define PG8_LAS __attribute__((address_space(3)))
typedef unsigned short bf16_t;
typedef short bf16x8 __attribute__((ext_vector_type(8)));
typedef float f32x4 __attribute__((ext_vector_type(4)));
typedef unsigned u32x4 __attribute__((ext_vector_type(4)));
constexpr int BM = 256, BK = 64, HALF = 128, HTB = HALF * BK * 2  , STAGE_BYTES = 8 * HTB, NXCD = 8, WGM = 8;

__host__ __device__ __forceinline__ int lds_byte(int r, int c) { const int st = (r >> 4) * 2 + (c >> 5), rr = r & 15, cc = c & 31, ob = rr * 64 + cc * 2; return st * 1024 + (ob ^ (((ob >> 9) & 1) << 5)); }
__host__ __device__ __forceinline__ void stage_rc(int b, int& R, int& C) { const int st = b / 1024, sb = b % 1024, swz = sb ^ (((sb >> 9) & 1) << 5); R = (st >> 1) * 16 + swz / 64; C = (st & 1) * 32 + (swz % 64) / 2; }
__host__ __device__ __forceinline__ int perm32(int rho) { const int n = rho >> 4, i = rho & 15; return 8 * (i >> 2) + 4 * n + (i & 3); }

struct Unit { int pm, pn; };
struct Gemm { const bf16_t* A; const bf16_t* Bt; int M, N, K; };

struct StaticOrder {
    int nM, nN, nwg, G, c;
    __host__ __device__ void init(int M, int N, int G_, int c_) { nM = M / BM; nN = N / BM; nwg = nM * nN; G = G_; c = c_; }
    __host__ __device__ bool next(int i, Unit& u) const {
        const long L = (long)i * G + c; if (L >= nwg) return false;
        int wgid = (int)L; { const int q = nwg / NXCD, r = nwg % NXCD, xcd = wgid % NXCD, off = wgid / NXCD; wgid = (xcd < r ? xcd * (q + 1) : r * (q + 1) + (xcd - r) * q) + off; }
        const int nig = WGM * nN, gid = wgid / nig, fm = gid * WGM, gsz = (nM - fm) < WGM ? (nM - fm) : WGM;
        u.pm = fm + ((wgid % nig) % gsz); u.pn = (wgid % nig) / gsz; return true;
    }
    __device__ __forceinline__ void a_ready(const Unit&) const {}
    __device__ __forceinline__ void done(const Unit&) const {}
};
__device__ __forceinline__ unsigned cvt_pk_bf16(float lo, float hi) { unsigned r; asm volatile("v_cvt_pk_bf16_f32 %0, %1, %2" : "=v"(r) : "v"(lo), "v"(hi)); return r; }
typedef float f32x2 __attribute__((ext_vector_type(2)));
constexpr float LOG2E = 1.44269504089f;
__device__ __forceinline__ float sigmoid_f(float x) { return __builtin_amdgcn_rcpf(1.0f + __builtin_amdgcn_exp2f(-LOG2E * x)); }
__device__ __forceinline__ float silu_f(float x) { return x * sigmoid_f(x); }
__device__ __forceinline__ float gelu_tanh_f(float x) { const float z = 1.5957691216f * (x + 0.044715f * x * x * x); return x * sigmoid_f(z); }
__device__ __forceinline__ f32x4 bf2_lo(unsigned a, unsigned b) { return (f32x4){__uint_as_float(a << 16), __uint_as_float(a & 0xffff0000u), __uint_as_float(b << 16), __uint_as_float(b & 0xffff0000u)}; }

constexpr int ROWS_P = 16384, ROWS_S = 512;
__host__ __device__ __forceinline__ int gext_row(int r) { return r < ROWS_P ? (r >> 11) * 2078 + 30 + (r & 2047) : 16624 + ((r - ROWS_P) >> 2) * 34 + 30 + ((r - ROWS_P) & 3); }
__host__ __device__ __forceinline__ int uext_row(int r) { return r < ROWS_P ? (r >> 11) * 2051 + 3 + (r & 2047) : 16408 + ((r - ROWS_P) >> 2) * 7 + 3 + ((r - ROWS_P) & 3); }

struct EpiRaw {
    static constexpr bool PERM = true, AFTER_DRAIN = false;
    bf16_t* O; int ldc;
    __device__ __forceinline__ void operator()(const f32x4 (&acc)[2][2][4][2], const Unit& u, int wr, int wc, int fr, int fq) const {
        const int row0 = u.pm * BM + wr * 64 + fr, col0 = u.pn * BM + wc * 32 + 8 * fq;
#pragma unroll
        for (int ai = 0; ai < 2; ++ai)
#pragma unroll
            for (int m = 0; m < 4; ++m) { bf16_t* rowp = O + (size_t)(row0 + ai * HALF + m * 16) * ldc + col0;
#pragma unroll
                for (int bj = 0; bj < 2; ++bj) { const f32x4 v0 = acc[ai][bj][m][0], v1 = acc[ai][bj][m][1];
                    u32x4 w; w.x = cvt_pk_bf16(v0[0], v0[1]); w.y = cvt_pk_bf16(v0[2], v0[3]); w.z = cvt_pk_bf16(v1[0], v1[1]); w.w = cvt_pk_bf16(v1[2], v1[3]);
                    *(u32x4*)(rowp + bj * HALF) = w; } }
    }
};
struct EpiSwiglu {
    static constexpr bool PERM = true, AFTER_DRAIN = false;
    bf16_t* O; int ldc;
    __device__ __forceinline__ void operator()(const f32x4 (&acc)[2][2][4][2], const Unit& u, int wr, int wc, int fr, int fq) const {
        const int row0 = u.pm * BM + wr * 64 + fr, col0 = u.pn * HALF + wc * 32 + 8 * fq;
#pragma unroll
        for (int ai = 0; ai < 2; ++ai)
#pragma unroll
            for (int m = 0; m < 4; ++m) { bf16_t* rowp = O + (size_t)(row0 + ai * HALF + m * 16) * ldc + col0;
                f32x4 h[2];
#pragma unroll
                for (int n = 0; n < 2; ++n) { const f32x4 g = acc[ai][0][m][n], up = acc[ai][1][m][n];
#pragma unroll
                    for (int j = 0; j < 4; ++j) h[n][j] = silu_f(g[j]) * up[j]; }
                u32x4 w; w.x = cvt_pk_bf16(h[0][0], h[0][1]); w.y = cvt_pk_bf16(h[0][2], h[0][3]); w.z = cvt_pk_bf16(h[1][0], h[1][1]); w.w = cvt_pk_bf16(h[1][2], h[1][3]);
                *(u32x4*)rowp = w; }
    }
};
struct EpiWin {
    static constexpr bool PERM = true, AFTER_DRAIN = false;
    float* gext; float* uext; bf16_t* gl;
    __device__ __forceinline__ void operator()(const f32x4 (&acc)[2][2][4][2], const Unit& u, int wr, int wc, int fr, int fq) const {
        const int row0 = u.pm * BM + wr * 64 + fr, c0 = wc * 32 + 8 * fq;
#pragma unroll
        for (int ai = 0; ai < 2; ++ai)
#pragma unroll
            for (int m = 0; m < 4; ++m) { const int r = row0 + ai * HALF + m * 16;
                if (u.pn < 4) { float* p = gext + (size_t)gext_row(r) * 512 + u.pn * HALF + c0;
#pragma unroll
                    for (int n = 0; n < 2; ++n) { const f32x4 v = acc[ai][0][m][n], gl_ = acc[ai][1][m][n]; f32x4 o;
#pragma unroll
                        for (int j = 0; j < 4; ++j) o[j] = v[j] * sigmoid_f(gl_[j]);
                        *(f32x4*)(p + 4 * n) = o; } }
                else if (u.pn < 6) { float* p = uext + (size_t)uext_row(r) * 512 + (u.pn - 4) * BM + c0;
#pragma unroll
                    for (int bj = 0; bj < 2; ++bj)
#pragma unroll
                        for (int n = 0; n < 2; ++n) *(f32x4*)(p + bj * HALF + 4 * n) = acc[ai][bj][m][n]; }
                else { bf16_t* p = gl + (size_t)r * 512 + (u.pn - 6) * BM + c0;
#pragma unroll
                    for (int bj = 0; bj < 2; ++bj) { f32x4 a = acc[ai][bj][m][0], b = acc[ai][bj][m][1];
#pragma unroll
                        for (int j = 0; j < 4; ++j) { a[j] = gelu_tanh_f(a[j]); b[j] = gelu_tanh_f(b[j]); }
                        u32x4 w; w.x = cvt_pk_bf16(a[0], a[1]); w.y = cvt_pk_bf16(a[2], a[3]); w.z = cvt_pk_bf16(b[0], b[1]); w.w = cvt_pk_bf16(b[2], b[3]);
                        *(u32x4*)(p + bj * HALF) = w; } }
            }
    }
};
struct EpiPle {
    static constexpr bool PERM = true, AFTER_DRAIN = false;
    const bf16_t* E; bf16_t* O; int ldc;
    __device__ __forceinline__ void operator()(const f32x4 (&acc)[2][2][4][2], const Unit& u, int wr, int wc, int fr, int fq) const {
        const int row0 = u.pm * BM + wr * 64 + fr, col0 = u.pn * BM + wc * 32 + 8 * fq;
#pragma unroll
        for (int ai = 0; ai < 2; ++ai)
#pragma unroll
            for (int m = 0; m < 4; ++m) { const size_t off = (size_t)(row0 + ai * HALF + m * 16) * ldc + col0;
#pragma unroll
                for (int bj = 0; bj < 2; ++bj) { const u32x4 e = *(const u32x4*)(E + off + bj * HALF); const f32x4 e0 = bf2_lo(e.x, e.y), e1 = bf2_lo(e.z, e.w);
                    f32x4 v0 = acc[ai][bj][m][0], v1 = acc[ai][bj][m][1];
#pragma unroll
                    for (int j = 0; j < 4; ++j) { v0[j] = sigmoid_f(v0[j]) * e0[j]; v1[j] = sigmoid_f(v1[j]) * e1[j]; }
                    u32x4 w; w.x = cvt_pk_bf16(v0[0], v0[1]); w.y = cvt_pk_bf16(v0[2], v0[3]); w.z = cvt_pk_bf16(v1[0], v1[1]); w.w = cvt_pk_bf16(v1[2], v1[3]);
                    *(u32x4*)(O + off + bj * HALF) = w; } }
    }
};
template <class Epi, class Sched, bool ALIGN_EPI = false, bool SP2 = false>
__device__ __forceinline__ void gemm_phase(PG8_LAS unsigned char* lds, const Gemm g, const Sched& S, const Epi& E) {
    int tid_ = threadIdx.x; asm volatile("" : "+v"(tid_));
    const int tid = tid_, wid = __builtin_amdgcn_readfirstlane(tid >> 6), lane = tid & 63, wr = wid >> 2, wc = wid & 3, fr = lane & 15, fq = lane >> 4;
    const int K = g.K, nt = K / BK;
    unsigned voffA[2], voffB[2];
#pragma unroll
    for (int i = 0; i < 2; ++i) { int R, C; stage_rc(tid * 16 + i * 8192, R, C); const int Rb = Epi::PERM ? ((R & ~31) + perm32(R & 31)) : R;
        voffA[i] = (unsigned)(R * K + C) * 2u; voffB[i] = (unsigned)(Rb * K + C) * 2u; }
    const size_t kstep = (size_t)(BK * 2);
    const size_t hstep = (size_t)HALF * K * 2;
    const size_t tstep = 2 * hstep;
    const unsigned ldsw = (unsigned)wid * 1024u;
    const int aoff = lds_byte(wr * 64 + fr, fq * 8), boff = lds_byte(wc * 32 + fr, fq * 8);
#define PG8_SA(b, h) (((b) * 2 + (h)) * HTB)
#define PG8_SB(b, h) ((4 + (b) * 2 + (h)) * HTB)
#define PG8_STAGE(bufoff, gbase, voff) do { _Pragma("unroll") for (int _i = 0; _i < 2; ++_i) \
        __builtin_amdgcn_global_load_lds((const unsigned*)((const char*)(gbase) + (voff)[_i]), (PG8_LAS unsigned*)(lds + (bufoff) + ldsw + _i * 8192), 16, 0, 0); } while (0)
#define PG8_LDA(dst, b, h) do { _Pragma("unroll") for (int m = 0; m < 4; ++m) _Pragma("unroll") for (int k = 0; k < 2; ++k) dst[m][k] = *(const PG8_LAS bf16x8*)(lds + PG8_SA(b, h) + aoff + m * 2048 + k * 1024); } while (0)
#define PG8_LDB(dst, b, h) do { _Pragma("unroll") for (int n = 0; n < 2; ++n) _Pragma("unroll") for (int k = 0; k < 2; ++k) dst[n][k] = *(const PG8_LAS bf16x8*)(lds + PG8_SB(b, h) + boff + n * 2048 + k * 1024); } while (0)
#define PG8_MMA(ai, bj, At, Bt) do { __builtin_amdgcn_s_setprio(1); _Pragma("unroll") for (int m = 0; m < 4; ++m) _Pragma("unroll") for (int n = 0; n < 2; ++n) _Pragma("unroll") for (int k = 0; k < 2; ++k) \
        acc[ai][bj][m][n] = __builtin_amdgcn_mfma_f32_16x16x32_bf16(Bt[n][k], At[m][k], acc[ai][bj][m][n], 0, 0, 0); __builtin_amdgcn_s_setprio(0); } while (0)
#define PG8_WAIT_V(n) asm volatile("s_waitcnt vmcnt(" #n ")" ::: "memory")
#define PG8_WAIT_L(n) asm volatile("s_waitcnt lgkmcnt(" #n ")" ::: "memory")
#define PG8_BAR __builtin_amdgcn_s_barrier()
#define PG8_SCHED __builtin_amdgcn_sched_barrier(0)
    Unit cur, nxt; int ui = 0;
    if (!S.next(0, cur)) return;
    f32x4 acc[2][2][4][2];
#pragma unroll
    for (int a = 0; a < 2; ++a)
#pragma unroll
        for (int b = 0; b < 2; ++b)
#pragma unroll
            for (int m = 0; m < 4; ++m)
#pragma unroll
                for (int n = 0; n < 2; ++n) acc[a][b][m][n] = (f32x4){0.f, 0.f, 0.f, 0.f};
    bf16x8 At[4][2], B0[2][2], B1[2][2];
    const char* cA = (const char*)g.A + (size_t)cur.pm * tstep; const char* cB = (const char*)g.Bt + (size_t)cur.pn * tstep;
    S.a_ready(cur);
    if constexpr (SP2) {
        PG8_STAGE(PG8_SB(0, 0), cB, voffB); PG8_STAGE(PG8_SB(0, 1), cB + hstep, voffB); PG8_STAGE(PG8_SA(0, 0), cA, voffA); PG8_STAGE(PG8_SA(0, 1), cA + hstep, voffA);
        if (wr == 1) PG8_BAR;
        PG8_WAIT_V(2); PG8_BAR;
        PG8_STAGE(PG8_SB(1, 0), cB + kstep, voffB); PG8_STAGE(PG8_SA(1, 0), cA + kstep, voffA); PG8_STAGE(PG8_SB(1, 1), cB + hstep + kstep, voffB);
        PG8_WAIT_V(6); PG8_BAR;
    } else {
        PG8_STAGE(PG8_SB(0, 0), cB, voffB); PG8_STAGE(PG8_SA(0, 0), cA, voffA); PG8_STAGE(PG8_SB(0, 1), cB + hstep, voffB); PG8_STAGE(PG8_SA(0, 1), cA + hstep, voffA);
        if (wr == 1) PG8_BAR;
        PG8_WAIT_V(4); PG8_BAR;
        PG8_STAGE(PG8_SB(1, 0), cB + kstep, voffB); PG8_STAGE(PG8_SA(1, 0), cA + kstep, voffA); PG8_STAGE(PG8_SB(1, 1), cB + hstep + kstep, voffB);
        PG8_WAIT_V(6); PG8_BAR;
    }
    for (;;) {
        const bool has_next = S.next(ui + 1, nxt);
        const char* nA = has_next ? (const char*)g.A + (size_t)nxt.pm * tstep : cA; const char* nB = has_next ? (const char*)g.Bt + (size_t)nxt.pn * tstep : cB;
        for (int t = 0; t < nt; t += 2) {
            const bool last = (t == nt - 2);
            const char* a1 = cA + (size_t)(t + 1) * kstep;
            const char* a2 = last ? nA : cA + (size_t)(t + 2) * kstep; const char* b2 = last ? nB : cB + (size_t)(t + 2) * kstep;
            const char* a3 = a2 + kstep; const char* b3 = b2 + kstep;
            if (last && has_next) S.a_ready(nxt);
            if constexpr (SP2) {
            PG8_LDB(B0, 0, 0); PG8_LDB(B1, 0, 1); PG8_SCHED; PG8_LDA(At, 0, 0); PG8_STAGE(PG8_SA(1, 1), a1 + hstep, voffA);
            PG8_WAIT_V(8); PG8_WAIT_L(0); PG8_BAR; PG8_MMA(0, 0, At, B0); PG8_MMA(0, 1, At, B1); PG8_BAR; PG8_SCHED;
            PG8_LDA(At, 0, 1); PG8_STAGE(PG8_SB(0, 0), b2, voffB); PG8_STAGE(PG8_SB(0, 1), b2 + hstep, voffB); PG8_STAGE(PG8_SA(0, 0), a2, voffA);
            PG8_WAIT_V(8); PG8_WAIT_L(0); PG8_BAR; PG8_MMA(1, 0, At, B0); PG8_MMA(1, 1, At, B1); PG8_BAR; PG8_SCHED;
            PG8_LDB(B0, 1, 0); PG8_LDB(B1, 1, 1); PG8_SCHED; PG8_LDA(At, 1, 0); PG8_STAGE(PG8_SA(0, 1), a2 + hstep, voffA);
            PG8_WAIT_V(8); PG8_WAIT_L(0); PG8_BAR; PG8_MMA(0, 0, At, B0); PG8_MMA(0, 1, At, B1); PG8_BAR; PG8_SCHED;
            PG8_LDA(At, 1, 1); PG8_STAGE(PG8_SB(1, 0), b3, voffB); PG8_STAGE(PG8_SB(1, 1), b3 + hstep, voffB); PG8_STAGE(PG8_SA(1, 0), a3, voffA);
            PG8_WAIT_V(8); PG8_WAIT_L(0); PG8_BAR; PG8_MMA(1, 0, At, B0); PG8_MMA(1, 1, At, B1); PG8_BAR; PG8_SCHED;
            } else {
            PG8_LDB(B0, 0, 0); PG8_SCHED; PG8_LDA(At, 0, 0); PG8_STAGE(PG8_SA(1, 1), a1 + hstep, voffA);
            PG8_WAIT_L(8); PG8_BAR; PG8_WAIT_L(0); PG8_MMA(0, 0, At, B0); PG8_BAR; PG8_SCHED;
            PG8_LDB(B1, 0, 1); PG8_STAGE(PG8_SB(0, 0), b2, voffB);
            PG8_BAR; PG8_WAIT_L(0); PG8_MMA(0, 1, At, B1); PG8_BAR;
            PG8_LDA(At, 0, 1); PG8_STAGE(PG8_SA(0, 0), a2, voffA);
            PG8_BAR; PG8_WAIT_L(0); PG8_MMA(1, 0, At, B0); PG8_BAR; PG8_SCHED;
            PG8_STAGE(PG8_SB(0, 1), b2 + hstep, voffB);
            PG8_WAIT_V(6); PG8_BAR; PG8_MMA(1, 1, At, B1); PG8_BAR;
            PG8_LDB(B0, 1, 0); PG8_SCHED; PG8_LDA(At, 1, 0); PG8_STAGE(PG8_SA(0, 1), a2 + hstep, voffA);
            PG8_WAIT_L(8); PG8_BAR; PG8_WAIT_L(0); PG8_MMA(0, 0, At, B0); PG8_BAR; PG8_SCHED;
            PG8_LDB(B1, 1, 1); PG8_STAGE(PG8_SB(1, 0), b3, voffB);
            PG8_BAR; PG8_WAIT_L(0); PG8_MMA(0, 1, At, B1); PG8_BAR;
            PG8_LDA(At, 1, 1); PG8_STAGE(PG8_SA(1, 0), a3, voffA);
            PG8_BAR; PG8_WAIT_L(0); PG8_MMA(1, 0, At, B0); PG8_BAR; PG8_SCHED;
            PG8_STAGE(PG8_SB(1, 1), b3 + hstep, voffB);
            PG8_WAIT_V(6); PG8_BAR; PG8_MMA(1, 1, At, B1); PG8_BAR;
            }
        }
        if constexpr (ALIGN_EPI) { if (wr == 0) PG8_BAR; }
        if constexpr (!Epi::AFTER_DRAIN) { E(acc, cur, wr, wc, fr, fq); S.done(cur); }
        if (!has_next) break;
#pragma unroll
        for (int a = 0; a < 2; ++a)
#pragma unroll
            for (int b = 0; b < 2; ++b)
#pragma unroll
                for (int m = 0; m < 4; ++m)
#pragma unroll
                    for (int n = 0; n < 2; ++n) acc[a][b][m][n] = (f32x4){0.f, 0.f, 0.f, 0.f};
        cur = nxt; cA = nA; cB = nB; ++ui;
        if constexpr (ALIGN_EPI) { if (wr == 1) PG8_BAR; }
    }
    PG8_WAIT_V(0);
    if constexpr (!ALIGN_EPI) { if (wr == 0) PG8_BAR; }
    PG8_BAR;
    if constexpr (Epi::AFTER_DRAIN) { E.fused(acc, cur, wr, wc, fr, fq, lds, wid, lane); S.done(cur); }
#undef PG8_SA
#undef PG8_SB
#undef PG8_STAGE
#undef PG8_LDA
#undef PG8_LDB
#undef PG8_MMA
#undef PG8_WAIT_V
#undef PG8_WAIT_L
#undef PG8_BAR
#undef PG8_SCHED
}
}
#define GAS __attribute__((address_space(1)))
#define LAS __attribute__((address_space(3)))
typedef unsigned short bf16;
typedef unsigned v4u __attribute__((ext_vector_type(4)));
typedef float f32x4 __attribute__((ext_vector_type(4)));
typedef short bf16x8 __attribute__((ext_vector_type(8)));
typedef GAS unsigned gu32;
typedef GAS unsigned long long gu64;
#define RLX_AGENT __ATOMIC_RELAXED, __HIP_MEMORY_SCOPE_AGENT
#define LDS_WAIT() asm volatile("s_waitcnt lgkmcnt(0)" ::: "memory")
#define VM_WAIT() asm volatile("s_waitcnt vmcnt(0)" ::: "memory")
__device__ __forceinline__ unsigned long long rt() { return __builtin_amdgcn_s_memrealtime(); }
__device__ __forceinline__ unsigned f2bf(float f) { unsigned u = __builtin_bit_cast(unsigned, f); return (u + 0x7fffu + ((u >> 16) & 1u)) >> 16; }
__device__ __forceinline__ unsigned pk2(float lo, float hi) { return f2bf(lo) | (f2bf(hi) << 16); }

#define XB_TMO      128
#define XB_XCNT(j)  (256  + 64 * (j))
#define XB_XSUB(j)  (1280 + 64 * (j))
#define XB_XGEN(j)  (2304 + 64 * (j))
#define XB_TOP      3328
#define XB_TOPGEN   3392
#define XCD_BAR_WORDS 3456
#define XB_SPIN_CAP (1u << 18)

__device__ __forceinline__ unsigned xb_ld(unsigned* p)              { return __hip_atomic_load(p, __ATOMIC_RELAXED, __HIP_MEMORY_SCOPE_AGENT); }
__device__ __forceinline__ unsigned xb_add(unsigned* p, unsigned v) { return __hip_atomic_fetch_add(p, v, __ATOMIC_RELAXED, __HIP_MEMORY_SCOPE_AGENT); }
__device__ __forceinline__ unsigned xb_xcc_id() { return (unsigned)__builtin_amdgcn_s_getreg((3 << 11) | 20) & 0xFu; }
#define XB_SPIN(cond, bar) do { unsigned _sp = 0; while (cond) { __builtin_amdgcn_s_sleep(1); \
    if ((++_sp & 255u) == 0u) { if (xb_ld(&(bar)[XB_TMO])) break; if (_sp > XB_SPIN_CAP) { atomicAdd(&(bar)[XB_TMO], 1u); break; } } } } while (0)

struct XcdBarrier {
    unsigned* bar; unsigned x;
    volatile LAS unsigned* st;
};

__device__ __forceinline__ XcdBarrier xcd_barrier_post(unsigned* bar, volatile LAS unsigned* st) {
    XcdBarrier b; b.bar = bar; b.x = xb_xcc_id(); b.st = st;
    if (threadIdx.x == 0) (void)xb_add(&bar[XB_XCNT(b.x)], 1u);
    return b;
}
__device__ __forceinline__ void xcd_barrier_complete(unsigned* bar, unsigned x, unsigned& nloc, unsigned& nx) {
    const unsigned G = gridDim.x * gridDim.y * gridDim.z;
    unsigned sum, cnt, mine, sp = 0u;
    for (;;) {
        sum = 0u; cnt = 0u; mine = 0u;
#pragma unroll
        for (unsigned j = 0; j < 16; ++j) { const unsigned c = xb_ld(&bar[XB_XCNT(j)]); sum += c; cnt += (c > 0u) ? 1u : 0u; mine = (j == x) ? c : mine; }
        if (sum == G) break;
        __builtin_amdgcn_s_sleep(1);
        if ((++sp & 255u) == 0u) { if (xb_ld(&bar[XB_TMO])) break; if (sp > XB_SPIN_CAP) { atomicAdd(&bar[XB_TMO], 1u); break; } }
    }
    nloc = mine > 0u ? mine : 1u; nx = cnt > 0u ? cnt : 1u;
}

__device__ __forceinline__ void xcd_barrier(const XcdBarrier& b) {
    asm volatile("s_waitcnt vmcnt(0)" ::: "memory");
    __syncthreads();
    if (threadIdx.x == 0) {
        unsigned* bar = b.bar;
        __builtin_amdgcn_s_waitcnt(0);
        unsigned nloc = b.st[0], nx = b.st[1];
        if (nloc == 0u) { xcd_barrier_complete(bar, b.x, nloc, nx); b.st[0] = nloc; b.st[1] = nx; }
        const unsigned old = xb_add(&bar[XB_XSUB(b.x)], 1u);
        const unsigned gen = old / nloc;
        if (old + 1u == (gen + 1u) * nloc) {
            __builtin_amdgcn_fence(__ATOMIC_RELEASE, "agent");
            asm volatile("s_waitcnt vmcnt(0)" ::: "memory");
            const unsigned og = xb_add(&bar[XB_TOP], 1u);
            const unsigned tg = og / nx;
            if (og + 1u == (tg + 1u) * nx) xb_add(&bar[XB_TOPGEN], 1u);
            else XB_SPIN(xb_ld(&bar[XB_TOPGEN]) == tg, bar);
            __builtin_amdgcn_fence(__ATOMIC_ACQUIRE, "agent");
            xb_add(&bar[XB_XGEN(b.x)], 1u);
            asm volatile("s_waitcnt vmcnt(0)" ::: "memory");
        } else {
            XB_SPIN(xb_ld(&bar[XB_XGEN(b.x)]) == gen, bar);
            __builtin_amdgcn_fence(__ATOMIC_ACQUIRE, "agent");
            asm volatile("s_waitcnt vmcnt(0)" ::: "memory");
        }
    }
    __syncthreads();
}
constexpr int NWAVES = 8;
constexpr int D = 1024, FF = 2816, NGU = 2 * FF, DC = 512, DL = 512, DIN = 2048, DPLE = 256;
constexpr int MP = 16384, MS = 512, M = MP + MS;
constexpr float EPS = 1e-6f;
constexpr int GEXT_ROWS = 16624 + 128 * 34, UEXT_ROWS = 16408 + 128 * 7;
constexpr size_t O_Y = 0, O_NCP = (size_t)M * D, O_NLCP = O_NCP + 8 * 30 * 512, O_NHP = O_NLCP + 8 * 3 * 512, O_NCS = O_NHP + 8 * 512, O_NLCS = O_NCS + 128 * 30 * 512, O_NHS = O_NLCS + 128 * 3 * 512, O_END = O_NHS + 128 * 512;
constexpr size_t MiB = 1u << 20;
constexpr size_t WS_CTL = 0, CTL_ZERO_BYTES = 1 * MiB;
constexpr size_t WS_WGU1 = 2 * MiB, WS_WD1 = 13 * MiB, WS_WGU2 = 19 * MiB, WS_WD2 = 30 * MiB, WS_WIN = 36 * MiB, WS_WOUT = 40 * MiB, WS_WPG = 42 * MiB, WS_WPP = 44 * MiB;
constexpr size_t WS_WAT = 45 * MiB;
constexpr size_t WS_SP8 = 45 * MiB + 512 * 1024;
constexpr size_t WS_SUM = 46 * MiB;
constexpr size_t WS_PB = 47 * MiB;
constexpr size_t WS_XA = 56 * MiB, WS_CAT = 89 * MiB, WS_RAW = 122 * MiB;
constexpr size_t WS_HID = 155 * MiB;
constexpr size_t WS_GEXT = 155 * MiB, WS_UEXT = 196 * MiB, WS_GL = 230 * MiB, WS_E = 155 * MiB, WS_END = 247 * MiB;
static_assert(WS_GEXT + (size_t)GEXT_ROWS * 2048 <= WS_UEXT && WS_UEXT + (size_t)UEXT_ROWS * 2048 <= WS_GL && WS_GL + (size_t)M * 512 * 2 <= WS_END && WS_HID + (size_t)M * FF * 2 <= WS_END, "d_ws map");
constexpr int LDS_BYTES = 147456;

__device__ __forceinline__ float wave_sum(float v) {
#pragma unroll
    for (int o = 1; o < 64; o <<= 1) v += __shfl_xor(v, o);
    return v;
}
__device__ __forceinline__ unsigned pkbf(float lo, float hi) { return pg8::cvt_pk_bf16(lo, hi); }

struct Frame {
    LAS unsigned char* lds;
    int tid, lane, wave, vcu, G;
    float* out; unsigned char* ws;
};
constexpr int PTAB_OFF = 131072 + 1024;
__device__ __forceinline__ const float* inp(const Frame& F, int i) { const LAS unsigned* t = (const LAS unsigned*)(F.lds + PTAB_OFF) + 2 * i;
    const unsigned lo = __builtin_amdgcn_readfirstlane(t[0]), hi = __builtin_amdgcn_readfirstlane(t[1]); return (const float*)(((unsigned long long)hi << 32) | lo); }
enum { I_XP = 0, I_XS, I_CACHE, I_SLC, I_SLH, I_PP, I_PS, I_F1PRE, I_F1POST, I_F1GU, I_F1DN, I_MPRE, I_MPOST, I_WIN, I_CW, I_CB, I_CNG, I_LCW, I_LCB, I_LWA, I_LBA, I_LWX, I_LBX, I_LAM, I_WOUT,
       I_F2PRE, I_F2POST, I_F2GU, I_F2DN, I_PNG, I_PWG, I_PWP, I_PPOST };
__device__ __forceinline__ const float* xrow(const Frame& F, int m) { return m < MP ? inp(F, I_XP) + (size_t)m * D : inp(F, I_XS) + (size_t)(m - MP) * D; }

__device__ __forceinline__ void p0_transpose_item(const float* W, int K, int N, bf16* WT, LAS float* scr, int k0, int n0dst, int n0src, int lane) {
#pragma unroll 8
    for (int i = 0; i < 32; ++i) { const int kk = 2 * i + (lane >> 5); scr[kk * 33 + (lane & 31)] = W[(size_t)(k0 + kk) * N + n0src + (lane & 31)]; }
    LDS_WAIT(); asm volatile("" ::: "memory");
    const int c = lane & 7;
#pragma unroll
    for (int j = 0; j < 4; ++j) { const int n = (lane >> 3) + 8 * j; const LAS float* s = scr + (8 * c) * 33 + n;
        v4u o; o.x = pkbf(s[0 * 33], s[1 * 33]); o.y = pkbf(s[2 * 33], s[3 * 33]); o.z = pkbf(s[4 * 33], s[5 * 33]); o.w = pkbf(s[6 * 33], s[7 * 33]);
        *(GAS v4u*)(WT + (size_t)(n0dst + n) * K + k0 + 8 * c) = o; }
    LDS_WAIT(); asm volatile("" ::: "memory");
}
__device__ __forceinline__ int cmap_gu(int n) { const int t = n >> 8, r = n & 255; return r < 128 ? t * 128 + r : FF + t * 128 + (r - 128); }
__device__ __forceinline__ int cmap_win(int n) { const int t = n >> 8, r = n & 255; return t < 4 ? (r < 128 ? t * 128 + r : 512 + t * 128 + (r - 128)) : n; }
__device__ __forceinline__ int lru_pi(int jrow) { const int nf = jrow >> 4, q = (jrow >> 2) & 3, r = jrow & 3; return 32 * (nf >> 1) + 8 * q + 4 * (nf & 1) + r; }

__device__ __forceinline__ void p0_prologue(Frame& F) {
    LAS float* scr = (LAS float*)(F.lds + F.wave * 16384);
    const int gw = F.vcu * NWAVES + F.wave, NGW = F.G * NWAVES;
    bf16* const ws16 = (bf16*)F.ws;
    constexpr int I_GU = (D / 64) * (NGU / 32), I_DN = (FF / 64) * (D / 32), I_IN = (D / 64) * (DIN / 32), I_SQ = (D / 64) * (D / 32), I_PP_ = (DPLE / 64) * (D / 32);
    constexpr int NITEMS = 2 * I_GU + 2 * I_DN + I_IN + 2 * I_SQ + I_PP_;
    for (int it = gw; it < NITEMS; it += NGW) {
        int r = it;
        if (r < 2 * I_GU) { const int f = r >= I_GU; r -= f * I_GU; const int nb = r % (NGU / 32), kb = r / (NGU / 32);
            p0_transpose_item(f ? inp(F, I_F2GU) : inp(F, I_F1GU), D, NGU, (bf16*)(F.ws + (f ? WS_WGU2 : WS_WGU1)), scr, 64 * kb, 32 * nb, cmap_gu(32 * nb), F.lane); continue; }
        r -= 2 * I_GU;
        if (r < 2 * I_DN) { const int f = r >= I_DN; r -= f * I_DN; const int nb = r % (D / 32), kb = r / (D / 32);
            p0_transpose_item(f ? inp(F, I_F2DN) : inp(F, I_F1DN), FF, D, (bf16*)(F.ws + (f ? WS_WD2 : WS_WD1)), scr, 64 * kb, 32 * nb, 32 * nb, F.lane); continue; }
        r -= 2 * I_DN;
        if (r < I_IN) { const int nb = r % (DIN / 32), kb = r / (DIN / 32);
            p0_transpose_item(inp(F, I_WIN), D, DIN, (bf16*)(F.ws + WS_WIN), scr, 64 * kb, 32 * nb, cmap_win(32 * nb), F.lane); continue; }
        r -= I_IN;
        if (r < 2 * I_SQ) { const int f = r >= I_SQ; r -= f * I_SQ; const int nb = r % (D / 32), kb = r / (D / 32);
            p0_transpose_item(f ? inp(F, I_PWG) : inp(F, I_WOUT), D, D, (bf16*)(F.ws + (f ? WS_WPG : WS_WOUT)), scr, 64 * kb, 32 * nb, 32 * nb, F.lane); continue; }
        r -= 2 * I_SQ;
        { const int nb = r % (D / 32), kb = r / (D / 32);
            p0_transpose_item(inp(F, I_PWP), DPLE, D, (bf16*)(F.ws + WS_WPP), scr, 64 * kb, 32 * nb, 32 * nb, F.lane); }
    }
    const int gt = gw * 64 + F.lane, NGT = NGW * 64;
    for (int e = gt; e < 2 * 8 * 64 * 64; e += NGT) { const int i = e & 63, jrow = (e >> 6) & 63, h = (e >> 12) & 7, g = e >> 15;
        const float w = (g ? inp(F, I_LWX) : inp(F, I_LWA))[(h * 64 + i) * 64 + lru_pi(jrow)]; ((bf16*)(F.ws + WS_WAT))[e] = (bf16)(pkbf(w, 0.f) & 0xffffu); }
    for (int e = gt; e < 512; e += NGT) { const float l = inp(F, I_LAM)[e]; const float sp = (l < -20.f) ? -l : log1pf(expf(-l)); ((float*)(F.ws + WS_SP8))[e] = 8.0f * sp; }
    for (int e = gt; e < M * DPLE / 4; e += NGT) { const int m = e >> 6, c4 = e & 63;
        const f32x4 v = *(const f32x4*)((m < MP ? inp(F, I_PP) + (size_t)m * DPLE : inp(F, I_PS) + (size_t)(m - MP) * DPLE) + 4 * c4);
        *(unsigned long long*)(ws16 + WS_PB / 2 + (size_t)m * DPLE + 4 * c4) = (unsigned long long)pkbf(v[0], v[1]) | ((unsigned long long)pkbf(v[2], v[3]) << 32); }
    { f32x4 gn[4];
#pragma unroll
        for (int j = 0; j < 4; ++j) gn[j] = ((const f32x4*)inp(F, I_F1PRE))[F.lane + 64 * j];
        for (int m = gw; m < M; m += NGW) { const f32x4* xr = (const f32x4*)xrow(F, m) + F.lane; f32x4 v[4]; float ss = 0.f;
#pragma unroll
            for (int j = 0; j < 4; ++j) { v[j] = xr[64 * j]; ss += (v[j][0] * v[j][0] + v[j][1] * v[j][1]) + (v[j][2] * v[j][2] + v[j][3] * v[j][3]); }
            const float rs = 1.0f / sqrtf(wave_sum(ss) * (1.0f / D) + EPS);
            unsigned long long* o8 = (unsigned long long*)(ws16 + WS_XA / 2 + (size_t)m * D) + F.lane;
#pragma unroll
            for (int j = 0; j < 4; ++j) { const f32x4 y = v[j] * rs * gn[j]; o8[64 * j] = (unsigned long long)pkbf(y[0], y[1]) | ((unsigned long long)pkbf(y[2], y[3]) << 32); } } }
}

__device__ __forceinline__ void init_history(Frame& F) {
    const int gw = F.vcu * NWAVES + F.wave, NGW = F.G * NWAVES; const int gt = gw * 64 + F.lane, NGT = NGW * 64;
    { float* gext = (float*)(F.ws + WS_GEXT); float* uext = (float*)(F.ws + WS_UEXT); const f32x4 z = {0.f, 0.f, 0.f, 0.f};
        for (int e = gt; e < 8 * 30 * 128; e += NGT) { const int c4 = e & 127, rr = e >> 7, b = rr / 30, i = rr % 30; *(f32x4*)(gext + (size_t)(b * 2078 + i) * 512 + 4 * c4) = z; }
        for (int e = gt; e < 128 * 30 * 128; e += NGT) { const int c4 = e & 127, rr = e >> 7, b = rr / 30, i = rr % 30;
            *(f32x4*)(gext + (size_t)(16624 + b * 34 + i) * 512 + 4 * c4) = *(const f32x4*)(inp(F, I_CACHE) + (size_t)rr * 512 + 4 * c4); }
        for (int e = gt; e < 8 * 3 * 128; e += NGT) { const int c4 = e & 127, rr = e >> 7, b = rr / 3, i = rr % 3; *(f32x4*)(uext + (size_t)(b * 2051 + i) * 512 + 4 * c4) = z; }
        for (int e = gt; e < 128 * 3 * 128; e += NGT) { const int c4 = e & 127, rr = e >> 7, b = rr / 3, i = rr % 3;
            *(f32x4*)(uext + (size_t)(16408 + b * 7 + i) * 512 + 4 * c4) = *(const f32x4*)(inp(F, I_SLC) + (size_t)rr * 512 + 4 * c4); } }
}

template <bool FROM_INPUT, bool WRITE_XA>
__device__ __forceinline__ void row_pass(Frame& F, float alpha, const float* gpost, const float* gpre) {
    const int gw = F.vcu * NWAVES + F.wave, NGW = F.G * NWAVES;
    const bf16* raw = (const bf16*)(F.ws + WS_RAW); bf16* xa = (bf16*)(F.ws + WS_XA);
    f32x4 gp[4], gn[4];
#pragma unroll
    for (int j = 0; j < 4; ++j) { gp[j] = ((const f32x4*)gpost)[F.lane + 64 * j]; if (WRITE_XA) gn[j] = ((const f32x4*)gpre)[F.lane + 64 * j]; }
    for (int m = gw; m < M; m += NGW) {
        const f32x4* br = (const f32x4*)(FROM_INPUT ? xrow(F, m) : F.out + (size_t)m * D) + F.lane;
        f32x4* orow = (f32x4*)(F.out + (size_t)m * D) + F.lane;
        const unsigned long long* rr = (const unsigned long long*)(raw + (size_t)m * D) + F.lane;
        f32x4 v[4], b[4]; float ss = 0.f;
#pragma unroll
        for (int j = 0; j < 4; ++j) { const unsigned long long w = rr[64 * j]; v[j] = pg8::bf2_lo((unsigned)w, (unsigned)(w >> 32)); b[j] = br[64 * j];
            ss += (v[j][0] * v[j][0] + v[j][1] * v[j][1]) + (v[j][2] * v[j][2] + v[j][3] * v[j][3]); }
        const float rs = alpha / sqrtf(wave_sum(ss) * (1.0f / D) + EPS); float s2 = 0.f;
#pragma unroll
        for (int j = 0; j < 4; ++j) { b[j] = b[j] + v[j] * rs * gp[j]; orow[64 * j] = b[j]; s2 += (b[j][0] * b[j][0] + b[j][1] * b[j][1]) + (b[j][2] * b[j][2] + b[j][3] * b[j][3]); }
        if (WRITE_XA) { const float r2 = 1.0f / sqrtf(wave_sum(s2) * (1.0f / D) + EPS);
            unsigned long long* o8 = (unsigned long long*)(xa + (size_t)m * D) + F.lane;
#pragma unroll
            for (int j = 0; j < 4; ++j) { const f32x4 y = b[j] * r2 * gn[j]; o8[64 * j] = (unsigned long long)pkbf(y[0], y[1]) | ((unsigned long long)pkbf(y[2], y[3]) << 32); } }
    }
}

template <int SEG>
__device__ __forceinline__ void conv_segment(Frame& F, const float* win, int out_row0, const float (&w)[31], float cb, float cg, LAS float* red) {
    float acc[SEG];
#pragma unroll
    for (int j = 0; j < SEG; ++j) acc[j] = cb;
#pragma unroll
    for (int r = 0; r < SEG + 30; ++r) { const float v = win[(size_t)r * 512];
#pragma unroll
        for (int j = 0; j < SEG; ++j) { const int k = r - j; if (k >= 0 && k < 31) acc[j] += w[k] * v; } }
#pragma unroll
    for (int j = 0; j < SEG; ++j) { const float q = wave_sum(acc[j] * acc[j]); if (F.lane == 0) red[F.wave * 16 + j] = q; }
    __syncthreads();
    bf16* cat = (bf16*)(F.ws + WS_CAT);
#pragma unroll
    for (int j = 0; j < SEG; ++j) { float t = 0.f;
#pragma unroll
        for (int w8 = 0; w8 < NWAVES; ++w8) t += red[w8 * 16 + j];
        const float rs = 1.0f / sqrtf(t * (1.0f / DC) + EPS);
        cat[(size_t)(out_row0 + j) * D + F.tid] = (bf16)(pkbf(pg8::silu_f(acc[j] * rs * cg), 0.f) & 0xffffu); }
    __syncthreads();
}

#define DPP_SHR(old, src, d) __uint_as_float(__builtin_amdgcn_update_dpp(__float_as_uint(old), __float_as_uint(src), 0x110 + (d), 0xf, 0xf, false))
__device__ __forceinline__ float bcast15(float v, int lane) { return __shfl(v, (lane & 48) | 15); }

template <int MODE>
__device__ __forceinline__ void lru_step(Frame& F, int h, int ub, int row, float (&hc)[4][4], float (&ar)[4][4]) {
    const int fr = F.lane & 15, fq = F.lane >> 4, cb0 = 64 * h + 8 * fq;
    const float* uext = (const float*)(F.ws + WS_UEXT);
    const float* lcw = inp(F, I_LCW); const float* lcb = inp(F, I_LCB);
    asm volatile("" ::: "memory");
    f32x4 xc[2][2];
#pragma unroll
    for (int s = 0; s < 2; ++s)
#pragma unroll
        for (int hf = 0; hf < 2; ++hf) { const int ch = cb0 + 32 * s + 4 * hf; f32x4 a = *(const f32x4*)(lcb + ch);
#pragma unroll
            for (int k = 0; k < 4; ++k) a += *(const f32x4*)(lcw + k * 512 + ch) * *(const f32x4*)(uext + (size_t)(ub + k) * 512 + ch);
            xc[s][hf] = a; }
    bf16x8 bfr[2];
#pragma unroll
    for (int s = 0; s < 2; ++s) { v4u t; t.x = pkbf(xc[s][0][0], xc[s][0][1]); t.y = pkbf(xc[s][0][2], xc[s][0][3]); t.z = pkbf(xc[s][1][0], xc[s][1][1]); t.w = pkbf(xc[s][1][2], xc[s][1][3]); bfr[s] = __builtin_bit_cast(bf16x8, t); }
    const bf16* wat = (const bf16*)(F.ws + WS_WAT);
    f32x4 av[4], bv[4];
#pragma unroll
    for (int nf = 0; nf < 4; ++nf) { f32x4 cr = {0.f, 0.f, 0.f, 0.f}, ci = {0.f, 0.f, 0.f, 0.f};
        asm volatile("" ::: "memory");
#pragma unroll
        for (int s = 0; s < 2; ++s) {
            const bf16x8 wr_ = *(const bf16x8*)(wat + (size_t)((0 * 8 + h) * 64 + 16 * nf + fr) * 64 + 32 * s + 8 * fq);
            const bf16x8 wi_ = *(const bf16x8*)(wat + (size_t)((1 * 8 + h) * 64 + 16 * nf + fr) * 64 + 32 * s + 8 * fq);
            cr = __builtin_amdgcn_mfma_f32_16x16x32_bf16(wr_, bfr[s], cr, 0, 0, 0);
            ci = __builtin_amdgcn_mfma_f32_16x16x32_bf16(wi_, bfr[s], ci, 0, 0, 0); }
        const int ch = cb0 + 32 * (nf >> 1) + 4 * (nf & 1);
        const f32x4 ba = *(const f32x4*)(inp(F, I_LBA) + ch), bx = *(const f32x4*)(inp(F, I_LBX) + ch), sp = *(const f32x4*)((const float*)(F.ws + WS_SP8) + ch);
        const f32x4 x = xc[nf >> 1][nf & 1];
#pragma unroll
        for (int r = 0; r < 4; ++r) { const float rg = pg8::sigmoid_f(cr[r] + ba[r]), ig = pg8::sigmoid_f(ci[r] + bx[r]);
            const float a = __builtin_amdgcn_exp2f(-pg8::LOG2E * rg * sp[r]);
            av[nf][r] = a; bv[nf][r] = sqrtf(fmaxf(1.0f - a * a, 0.f)) * (ig * x[r]); } }
#pragma unroll
    for (int nf = 0; nf < 4; ++nf)
#pragma unroll
        for (int r = 0; r < 4; ++r) { float a = av[nf][r], b = bv[nf][r];
            if (MODE == 2) {
                { float ap = DPP_SHR(1.0f, a, 1), bp = DPP_SHR(0.f, b, 1); if ((fr & 3) < 1) { ap = 1.0f; bp = 0.f; } b = a * bp + b; a = a * ap; }
                { float ap = DPP_SHR(1.0f, a, 2), bp = DPP_SHR(0.f, b, 2); if ((fr & 3) < 2) { ap = 1.0f; bp = 0.f; } b = a * bp + b; a = a * ap; }
            } else {
                { const float ap = DPP_SHR(1.0f, a, 1), bp = DPP_SHR(0.f, b, 1); b = a * bp + b; a = a * ap; }
                { const float ap = DPP_SHR(1.0f, a, 2), bp = DPP_SHR(0.f, b, 2); b = a * bp + b; a = a * ap; }
                { const float ap = DPP_SHR(1.0f, a, 4), bp = DPP_SHR(0.f, b, 4); b = a * bp + b; a = a * ap; }
                { const float ap = DPP_SHR(1.0f, a, 8), bp = DPP_SHR(0.f, b, 8); b = a * bp + b; a = a * ap; }
            }
            av[nf][r] = a; bv[nf][r] = b; }
    if (MODE == 0) {
#pragma unroll
        for (int nf = 0; nf < 4; ++nf)
#pragma unroll
            for (int r = 0; r < 4; ++r) { const float a15 = bcast15(av[nf][r], F.lane), h15 = bcast15(bv[nf][r], F.lane); hc[nf][r] = h15 + a15 * hc[nf][r]; ar[nf][r] *= a15; }
    } else {
        const bf16* gl = (const bf16*)(F.ws + WS_GL); bf16* cat = (bf16*)(F.ws + WS_CAT);
#pragma unroll
        for (int nf = 0; nf < 4; ++nf) { const int chl = 8 * fq + 32 * (nf >> 1) + 4 * (nf & 1);
            const unsigned long long gw_ = *(const unsigned long long*)(gl + (size_t)row * 512 + 64 * h + chl); const f32x4 gg = pg8::bf2_lo((unsigned)gw_, (unsigned)(gw_ >> 32));
            f32x4 hv;
#pragma unroll
            for (int r = 0; r < 4; ++r) hv[r] = bv[nf][r] + av[nf][r] * hc[nf][r];
            *(unsigned long long*)(cat + (size_t)row * D + DC + 64 * h + chl) = (unsigned long long)pkbf(hv[0] * gg[0], hv[1] * gg[1]) | ((unsigned long long)pkbf(hv[2] * gg[2], hv[3] * gg[3]) << 32);
            if (MODE == 1) {
#pragma unroll
                for (int r = 0; r < 4; ++r) hc[nf][r] = bcast15(hv[r], F.lane);
                if ((row & 2047) == 2047) *(f32x4*)(F.out + O_NHP + (size_t)(row >> 11) * 512 + 64 * h + chl) = hv;
            } else {
                if ((fr & 3) == 3) *(f32x4*)(F.out + O_NHS + (size_t)((row - MP) >> 2) * 512 + 64 * h + chl) = hv;
            } }
    }
}

__device__ __forceinline__ void mid_pass1(Frame& F0) {
    Frame F = F0; asm volatile("" : "+v"(F.tid), "+v"(F.lane));
    LAS float* red = (LAS float*)F.lds;
    const float* gext = (const float*)(F.ws + WS_GEXT);
    float w[31];
#pragma unroll
    for (int k = 0; k < 31; ++k) w[k] = inp(F, I_CW)[k * 512 + F.tid];
    const float cb = inp(F, I_CB)[F.tid], cg = inp(F, I_CNG)[F.tid];
    for (int c = F.vcu; c < 256; c += F.G) { const int b = c >> 5, t0 = (c & 31) * 64;
#pragma unroll 1
        for (int q = 0; q < 4; ++q) conv_segment<16>(F, gext + (size_t)(b * 2078 + t0 + 16 * q) * 512 + F.tid, b * 2048 + t0 + 16 * q, w, cb, cg, red); }
    for (int sg = F.vcu; sg < 32; sg += F.G)
#pragma unroll 1
        for (int i = 0; i < 4; ++i) conv_segment<4>(F, gext + (size_t)(16624 + (4 * sg + i) * 34) * 512 + F.tid, MP + (4 * sg + i) * 4, w, cb, cg, red);
    { const int gt = (F.vcu * NWAVES + F.wave) * 64 + F.lane, NGT = F.G * NWAVES * 64; const float* uext = (const float*)(F.ws + WS_UEXT);
        for (int e = gt; e < 8 * 30 * 128; e += NGT) { const int c4 = e & 127, rr = e >> 7, b = rr / 30, i = rr % 30; *(f32x4*)(F.out + O_NCP + (size_t)rr * 512 + 4 * c4) = *(const f32x4*)(gext + (size_t)(b * 2078 + 2048 + i) * 512 + 4 * c4); }
        for (int e = gt; e < 128 * 30 * 128; e += NGT) { const int c4 = e & 127, rr = e >> 7, b = rr / 30, i = rr % 30; *(f32x4*)(F.out + O_NCS + (size_t)rr * 512 + 4 * c4) = *(const f32x4*)(gext + (size_t)(16624 + b * 34 + 4 + i) * 512 + 4 * c4); }
        for (int e = gt; e < 8 * 3 * 128; e += NGT) { const int c4 = e & 127, rr = e >> 7, b = rr / 3, i = rr % 3; *(f32x4*)(F.out + O_NLCP + (size_t)rr * 512 + 4 * c4) = *(const f32x4*)(uext + (size_t)(b * 2051 + 2048 + i) * 512 + 4 * c4); }
        for (int e = gt; e < 128 * 3 * 128; e += NGT) { const int c4 = e & 127, rr = e >> 7, b = rr / 3, i = rr % 3; *(f32x4*)(F.out + O_NLCS + (size_t)rr * 512 + 4 * c4) = *(const f32x4*)(uext + (size_t)(16408 + b * 7 + 4 + i) * 512 + 4 * c4); } }
    const int h = F.wave, fr = F.lane & 15, fq = F.lane >> 4;
    for (int c = F.vcu; c < 256; c += F.G) { const int b = c >> 5, t0 = (c & 31) * 64;
        float hc[4][4], ar[4][4];
#pragma unroll
        for (int nf = 0; nf < 4; ++nf)
#pragma unroll
            for (int r = 0; r < 4; ++r) { hc[nf][r] = 0.f; ar[nf][r] = 1.0f; }
#pragma unroll 1
        for (int st = 0; st < 4; ++st) lru_step<0>(F, h, b * 2051 + t0 + 16 * st + fr, b * 2048 + t0 + 16 * st + fr, hc, ar);
        if (fr == 0) { float* sum = (float*)(F.ws + WS_SUM) + ((size_t)c * 512 + 64 * h + 8 * fq) * 2;
#pragma unroll
            for (int nf = 0; nf < 4; ++nf) { float* p = sum + (32 * (nf >> 1) + 4 * (nf & 1)) * 2;
                *(f32x4*)p = (f32x4){ar[nf][0], hc[nf][0], ar[nf][1], hc[nf][1]}; *(f32x4*)(p + 4) = (f32x4){ar[nf][2], hc[nf][2], ar[nf][3], hc[nf][3]}; } } }
    for (int sg = F.vcu; sg < 32; sg += F.G) { const int bb = 4 * sg + (fr >> 2), t = fr & 3;
        float hc[4][4], ar[4][4];
#pragma unroll
        for (int nf = 0; nf < 4; ++nf) { const f32x4 h0 = *(const f32x4*)(inp(F, I_SLH) + (size_t)bb * 512 + 64 * h + 8 * fq + 32 * (nf >> 1) + 4 * (nf & 1));
#pragma unroll
            for (int r = 0; r < 4; ++r) { hc[nf][r] = h0[r]; ar[nf][r] = 1.0f; } }
        lru_step<2>(F, h, 16408 + bb * 7 + t, MP + bb * 4 + t, hc, ar); }
}
__device__ __forceinline__ void mid_pass2(Frame& F0) {
    Frame F = F0; asm volatile("" : "+v"(F.tid), "+v"(F.lane));
    const int h = F.wave, fr = F.lane & 15, fq = F.lane >> 4;
    for (int c = F.vcu; c < 256; c += F.G) { const int b = c >> 5, t0 = (c & 31) * 64;
        float hc[4][4], ar[4][4];
#pragma unroll
        for (int nf = 0; nf < 4; ++nf)
#pragma unroll
            for (int r = 0; r < 4; ++r) { hc[nf][r] = 0.f; ar[nf][r] = 1.0f; }
#pragma unroll 1
        for (int cc = b * 32; cc < c; ++cc) { const float* sum = (const float*)(F.ws + WS_SUM) + ((size_t)cc * 512 + 64 * h + 8 * fq) * 2;
#pragma unroll
            for (int nf = 0; nf < 4; ++nf) { const float* p = sum + (32 * (nf >> 1) + 4 * (nf & 1)) * 2; const f32x4 s0 = *(const f32x4*)p, s1 = *(const f32x4*)(p + 4);
                hc[nf][0] = s0[0] * hc[nf][0] + s0[1]; hc[nf][1] = s0[2] * hc[nf][1] + s0[3]; hc[nf][2] = s1[0] * hc[nf][2] + s1[1]; hc[nf][3] = s1[2] * hc[nf][3] + s1[3]; } }
#pragma unroll 1
        for (int st = 0; st < 4; ++st) lru_step<1>(F, h, b * 2051 + t0 + 16 * st + fr, b * 2048 + t0 + 16 * st + fr, hc, ar); }
}

struct Args { const float* in[33]; float* out; unsigned char* ws; };
__global__ void __launch_bounds__(NWAVES * 64, 2) hymba_fwd(Args args) {
    extern __shared__ __attribute__((aligned(16))) unsigned char lds_raw[];
    cg::grid_group grid = cg::this_grid();
    Frame F;
    F.lds = (LAS unsigned char*)lds_raw;
    F.tid = threadIdx.x; F.lane = F.tid & 63; F.wave = __builtin_amdgcn_readfirstlane(F.tid >> 6);
    F.G = gridDim.x; { const int bx = blockIdx.x; F.vcu = (F.G % 8 == 0) ? (bx % 8) * (F.G / 8) + bx / 8 : bx; }
    if (F.tid < 33) ((LAS unsigned long long*)(F.lds + PTAB_OFF))[F.tid] = (unsigned long long)args.in[F.tid];
    __syncthreads();
    F.out = args.out; F.ws = args.ws;
    bf16* const XA = (bf16*)(F.ws + WS_XA); bf16* const CAT = (bf16*)(F.ws + WS_CAT); bf16* const RAW = (bf16*)(F.ws + WS_RAW); bf16* const HID = (bf16*)(F.ws + WS_HID);
#define GRID_BAR() grid.sync()

    p0_prologue(F);
    GRID_BAR();
#pragma unroll 1
    for (int f = 0; f < 2; ++f) {
        { pg8::Gemm g{XA, (const bf16*)(F.ws + (f ? WS_WGU2 : WS_WGU1)), M, NGU, D}; pg8::StaticOrder S; S.init(M, NGU, F.G, (int)blockIdx.x);
          pg8::EpiSwiglu E{HID, FF};
          pg8::gemm_phase<pg8::EpiSwiglu, pg8::StaticOrder, true, true>(F.lds, g, S, E); }
        GRID_BAR();
        { pg8::Gemm g{HID, (const bf16*)(F.ws + (f ? WS_WD2 : WS_WD1)), M, D, FF}; pg8::StaticOrder S; S.init(M, D, F.G, (int)blockIdx.x);
          pg8::EpiRaw E{RAW, D};
          pg8::gemm_phase<pg8::EpiRaw, pg8::StaticOrder, true, true>(F.lds, g, S, E); }
        GRID_BAR();
        if (f == 0) { row_pass<true, true>(F, 0.5f, inp(F, I_F1POST), inp(F, I_MPRE)); init_history(F); }
        else        row_pass<false, true>(F, 0.5f, inp(F, I_F2POST), inp(F, I_PNG));
        GRID_BAR();
        if (f == 0) {
            { pg8::Gemm g{XA, (const bf16*)(F.ws + WS_WIN), M, DIN, D}; pg8::StaticOrder S; S.init(M, DIN, F.G, (int)blockIdx.x);
              pg8::EpiWin E{(float*)(F.ws + WS_GEXT), (float*)(F.ws + WS_UEXT), (bf16*)(F.ws + WS_GL)};
              pg8::gemm_phase<pg8::EpiWin, pg8::StaticOrder, true, true>(F.lds, g, S, E); }
            GRID_BAR();
            mid_pass1(F);
            GRID_BAR();
            mid_pass2(F);
            GRID_BAR();
            { pg8::Gemm g{CAT, (const bf16*)(F.ws + WS_WOUT), M, D, D}; pg8::StaticOrder S; S.init(M, D, F.G, (int)blockIdx.x);
              pg8::EpiRaw E{RAW, D};
              pg8::gemm_phase<pg8::EpiRaw, pg8::StaticOrder, true, true>(F.lds, g, S, E); }
            GRID_BAR();
            row_pass<false, true>(F, 1.0f, inp(F, I_MPOST), inp(F, I_F2PRE));
            GRID_BAR();
        }
    }
    { pg8::Gemm g{(const bf16*)(F.ws + WS_PB), (const bf16*)(F.ws + WS_WPP), M, D, DPLE}; pg8::StaticOrder S; S.init(M, D, F.G, (int)blockIdx.x);
      pg8::EpiRaw E{(bf16*)(F.ws + WS_E), D};
      pg8::gemm_phase<pg8::EpiRaw, pg8::StaticOrder, true, true>(F.lds, g, S, E); }
    GRID_BAR();
    { pg8::Gemm g{XA, (const bf16*)(F.ws + WS_WPG), M, D, D}; pg8::StaticOrder S; S.init(M, D, F.G, (int)blockIdx.x);
      pg8::EpiPle E{(const bf16*)(F.ws + WS_E), RAW, D};
      pg8::gemm_phase<pg8::EpiPle, pg8::StaticOrder, true, true>(F.lds, g, S, E); }
    GRID_BAR();
    row_pass<false, false>(F, 1.0f, inp(F, I_PPOST), nullptr);
}

extern "C" void kernel_launch(void* const* d_in, const int* in_sizes, int n_in, void* d_out, int out_size, void* d_ws, size_t ws_size, hipStream_t stream) {
    static int grid = 0;
    if (grid == 0) {
        if (n_in != 33 || out_size != (int)O_END || ws_size < WS_END) { fprintf(stderr, "kernel_launch: unexpected shapes (n_in %d out %d ws %zu)\n", n_in, out_size, ws_size); grid = -1; return; }
        int dev = 0, cus = 0, per_cu = 0;
        if (hipGetDevice(&dev) != hipSuccess || hipDeviceGetAttribute(&cus, hipDeviceAttributeMultiprocessorCount, dev) != hipSuccess) { grid = -1; return; }
        if (hipFuncSetAttribute((const void*)hymba_fwd, hipFuncAttributeMaxDynamicSharedMemorySize, LDS_BYTES) != hipSuccess) { fprintf(stderr, "kernel_launch: hipFuncSetAttribute failed\n"); grid = -1; return; }
        if (hipOccupancyMaxActiveBlocksPerMultiprocessor(&per_cu, (const void*)hymba_fwd, NWAVES * 64, LDS_BYTES) != hipSuccess || per_cu < 1) { fprintf(stderr, "kernel_launch: occupancy query failed (%d)\n", per_cu); (void)hipGetLastError(); per_cu = 1; }
        grid = cus;
        fprintf(stderr, "kernel_launch: cus %d per_cu %d grid %d\n", cus, per_cu, grid);
    }
    if (grid < 0) return;
    (void)hipMemsetAsync((char*)d_ws + WS_CTL, 0, CTL_ZERO_BYTES, stream);
    Args a{};
    for (int i = 0; i < 33; ++i) a.in[i] = (const float*)d_in[i];
    a.out = (float*)d_out; a.ws = (unsigned char*)d_ws;
    void* kargs[] = {&a};
    const hipError_t e = hipLaunchCooperativeKernel((const void*)hymba_fwd, dim3(grid), dim3(NWAVES * 64), kargs, LDS_BYTES, stream);
    if (e != hipSuccess) fprintf(stderr, "kernel_launch: cooperative launch failed: %s (grid %d)\n", hipGetErrorString(e), grid);
}
```

```cpp
#include <hip/hip_runtime.h>
#include <hip/hip_cooperative_groups.h>
#include <cstdio>
#include <cstdint>
namespace cg = cooperative_groups;
namespace pg8 {
#define PG8_LAS __attribute__((address_space(3)))
typedef unsigned short bf16_t;
typedef short bf16x8 __attribute__((ext_vector_type(8)));
typedef float f32x4 __attribute__((ext_vector_type(4)));
typedef unsigned u32x4 __attribute__((ext_vector_type(4)));
constexpr int BM = 256, BK = 64, HALF = 128, HTB = HALF * BK * 2  , STAGE_BYTES = 8 * HTB, NXCD = 8, WGM = 8;

__host__ __device__ __forceinline__ int lds_byte(int r, int c) { const int st = (r >> 4) * 2 + (c >> 5), rr = r & 15, cc = c & 31, ob = rr * 64 + cc * 2; return st * 1024 + (ob ^ (((ob >> 9) & 1) << 5)); }
__host__ __device__ __forceinline__ void stage_rc(int b, int& R, int& C) { const int st = b / 1024, sb = b % 1024, swz = sb ^ (((sb >> 9) & 1) << 5); R = (st >> 1) * 16 + swz / 64; C = (st & 1) * 32 + (swz % 64) / 2; }
__host__ __device__ __forceinline__ int perm32(int rho) { const int n = rho >> 4, i = rho & 15; return 8 * (i >> 2) + 4 * n + (i & 3); }

struct Unit { int pm, pn; };
struct Gemm { const bf16_t* A; const bf16_t* Bt; int M, N, K; };

struct StaticOrder {
    int nM, nN, nwg, G, c;
    __host__ __device__ void init(int M, int N, int G_, int c_) { nM = M / BM; nN = N / BM; nwg = nM * nN; G = G_; c = c_; }
    __host__ __device__ bool next(int i, Unit& u) const {
        const long L = (long)i * G + c; if (L >= nwg) return false;
        int wgid = (int)L; { const int q = nwg / NXCD, r = nwg % NXCD, xcd = wgid % NXCD, off = wgid / NXCD; wgid = (xcd < r ? xcd * (q + 1) : r * (q + 1) + (xcd - r) * q) + off; }
        const int nig = WGM * nN, gid = wgid / nig, fm = gid * WGM, gsz = (nM - fm) < WGM ? (nM - fm) : WGM;
        u.pm = fm + ((wgid % nig) % gsz); u.pn = (wgid % nig) / gsz; return true;
    }
    __device__ __forceinline__ void a_ready(const Unit&) const {}
    __device__ __forceinline__ void done(const Unit&) const {}
};
__device__ __forceinline__ unsigned cvt_pk_bf16(float lo, float hi) { unsigned r; asm volatile("v_cvt_pk_bf16_f32 %0, %1, %2" : "=v"(r) : "v"(lo), "v"(hi)); return r; }
typedef float f32x2 __attribute__((ext_vector_type(2)));
constexpr float LOG2E = 1.44269504089f;
__device__ __forceinline__ float sigmoid_f(float x) { return __builtin_amdgcn_rcpf(1.0f + __builtin_amdgcn_exp2f(-LOG2E * x)); }
__device__ __forceinline__ float silu_f(float x) { return x * sigmoid_f(x); }
__device__ __forceinline__ float gelu_tanh_f(float x) { const float z = 1.5957691216f * (x + 0.044715f * x * x * x); return x * sigmoid_f(z); }
__device__ __forceinline__ f32x4 bf2_lo(unsigned a, unsigned b) { return (f32x4){__uint_as_float(a << 16), __uint_as_float(a & 0xffff0000u), __uint_as_float(b << 16), __uint_as_float(b & 0xffff0000u)}; }

constexpr int ROWS_P = 16384, ROWS_S = 512;
__host__ __device__ __forceinline__ int gext_row(int r) { return r < ROWS_P ? (r >> 11) * 2078 + 30 + (r & 2047) : 16624 + ((r - ROWS_P) >> 2) * 34 + 30 + ((r - ROWS_P) & 3); }
__host__ __device__ __forceinline__ int uext_row(int r) { return r < ROWS_P ? (r >> 11) * 2051 + 3 + (r & 2047) : 16408 + ((r - ROWS_P) >> 2) * 7 + 3 + ((r - ROWS_P) & 3); }

struct EpiRaw {
    static constexpr bool PERM = true, AFTER_DRAIN = false;
    bf16_t* O; int ldc;
    __device__ __forceinline__ void operator()(const f32x4 (&acc)[2][2][4][2], const Unit& u, int wr, int wc, int fr, int fq) const {
        const int row0 = u.pm * BM + wr * 64 + fr, col0 = u.pn * BM + wc * 32 + 8 * fq;
#pragma unroll
        for (int ai = 0; ai < 2; ++ai)
#pragma unroll
            for (int m = 0; m < 4; ++m) { bf16_t* rowp = O + (size_t)(row0 + ai * HALF + m * 16) * ldc + col0;
#pragma unroll
                for (int bj = 0; bj < 2; ++bj) { const f32x4 v0 = acc[ai][bj][m][0], v1 = acc[ai][bj][m][1];
                    u32x4 w; w.x = cvt_pk_bf16(v0[0], v0[1]); w.y = cvt_pk_bf16(v0[2], v0[3]); w.z = cvt_pk_bf16(v1[0], v1[1]); w.w = cvt_pk_bf16(v1[2], v1[3]);
                    *(u32x4*)(rowp + bj * HALF) = w; } }
    }
};
struct EpiSwiglu {
    static constexpr bool PERM = true, AFTER_DRAIN = false;
    bf16_t* O; int ldc;
    __device__ __forceinline__ void operator()(const f32x4 (&acc)[2][2][4][2], const Unit& u, int wr, int wc, int fr, int fq) const {
        const int row0 = u.pm * BM + wr * 64 + fr, col0 = u.pn * HALF + wc * 32 + 8 * fq;
#pragma unroll
        for (int ai = 0; ai < 2; ++ai)
#pragma unroll
            for (int m = 0; m < 4; ++m) { bf16_t* rowp = O + (size_t)(row0 + ai * HALF + m * 16) * ldc + col0;
                f32x4 h[2];
#pragma unroll
                for (int n = 0; n < 2; ++n) { const f32x4 g = acc[ai][0][m][n], up = acc[ai][1][m][n];
#pragma unroll
                    for (int j = 0; j < 4; ++j) h[n][j] = silu_f(g[j]) * up[j]; }
                u32x4 w; w.x = cvt_pk_bf16(h[0][0], h[0][1]); w.y = cvt_pk_bf16(h[0][2], h[0][3]); w.z = cvt_pk_bf16(h[1][0], h[1][1]); w.w = cvt_pk_bf16(h[1][2], h[1][3]);
                *(u32x4*)rowp = w; }
    }
};
struct EpiWin {
    static constexpr bool PERM = true, AFTER_DRAIN = false;
    float* gext; float* uext; bf16_t* gl;
    __device__ __forceinline__ void operator()(const f32x4 (&acc)[2][2][4][2], const Unit& u, int wr, int wc, int fr, int fq) const {
        const int row0 = u.pm * BM + wr * 64 + fr, c0 = wc * 32 + 8 * fq;
#pragma unroll
        for (int ai = 0; ai < 2; ++ai)
#pragma unroll
            for (int m = 0; m < 4; ++m) { const int r = row0 + ai * HALF + m * 16;
                if (u.pn < 4) { float* p = gext + (size_t)gext_row(r) * 512 + u.pn * HALF + c0;
#pragma unroll
                    for (int n = 0; n < 2; ++n) { const f32x4 v = acc[ai][0][m][n], gl_ = acc[ai][1][m][n]; f32x4 o;
#pragma unroll
                        for (int j = 0; j < 4; ++j) o[j] = v[j] * sigmoid_f(gl_[j]);
                        *(f32x4*)(p + 4 * n) = o; } }
                else if (u.pn < 6) { float* p = uext + (size_t)uext_row(r) * 512 + (u.pn - 4) * BM + c0;
#pragma unroll
                    for (int bj = 0; bj < 2; ++bj)
#pragma unroll
                        for (int n = 0; n < 2; ++n) *(f32x4*)(p + bj * HALF + 4 * n) = acc[ai][bj][m][n]; }
                else { bf16_t* p = gl + (size_t)r * 512 + (u.pn - 6) * BM + c0;
#pragma unroll
                    for (int bj = 0; bj < 2; ++bj) { f32x4 a = acc[ai][bj][m][0], b = acc[ai][bj][m][1];
#pragma unroll
                        for (int j = 0; j < 4; ++j) { a[j] = gelu_tanh_f(a[j]); b[j] = gelu_tanh_f(b[j]); }
                        u32x4 w; w.x = cvt_pk_bf16(a[0], a[1]); w.y = cvt_pk_bf16(a[2], a[3]); w.z = cvt_pk_bf16(b[0], b[1]); w.w = cvt_pk_bf16(b[2], b[3]);
                        *(u32x4*)(p + bj * HALF) = w; } }
            }
    }
};
struct EpiPle {
    static constexpr bool PERM = true, AFTER_DRAIN = false;
    const bf16_t* E; bf16_t* O; int ldc;
    __device__ __forceinline__ void operator()(const f32x4 (&acc)[2][2][4][2], const Unit& u, int wr, int wc, int fr, int fq) const {
        const int row0 = u.pm * BM + wr * 64 + fr, col0 = u.pn * BM + wc * 32 + 8 * fq;
#pragma unroll
        for (int ai = 0; ai < 2; ++ai)
#pragma unroll
            for (int m = 0; m < 4; ++m) { const size_t off = (size_t)(row0 + ai * HALF + m * 16) * ldc + col0;
#pragma unroll
                for (int bj = 0; bj < 2; ++bj) { const u32x4 e = *(const u32x4*)(E + off + bj * HALF); const f32x4 e0 = bf2_lo(e.x, e.y), e1 = bf2_lo(e.z, e.w);
                    f32x4 v0 = acc[ai][bj][m][0], v1 = acc[ai][bj][m][1];
#pragma unroll
                    for (int j = 0; j < 4; ++j) { v0[j] = sigmoid_f(v0[j]) * e0[j]; v1[j] = sigmoid_f(v1[j]) * e1[j]; }
                    u32x4 w; w.x = cvt_pk_bf16(v0[0], v0[1]); w.y = cvt_pk_bf16(v0[2], v0[3]); w.z = cvt_pk_bf16(v1[0], v1[1]); w.w = cvt_pk_bf16(v1[2], v1[3]);
                    *(u32x4*)(O + off + bj * HALF) = w; } }
    }
};
template <class Epi, class Sched, bool ALIGN_EPI = false, bool SP2 = false>
__device__ __forceinline__ void gemm_phase(PG8_LAS unsigned char* lds, const Gemm g, const Sched& S, const Epi& E) {
    int tid_ = threadIdx.x; asm volatile("" : "+v"(tid_));
    const int tid = tid_, wid = __builtin_amdgcn_readfirstlane(tid >> 6), lane = tid & 63, wr = wid >> 2, wc = wid & 3, fr = lane & 15, fq = lane >> 4;
    const int K = g.K, nt = K / BK;
    unsigned voffA[2], voffB[2];
#pragma unroll
    for (int i = 0; i < 2; ++i) { int R, C; stage_rc(tid * 16 + i * 8192, R, C); const int Rb = Epi::PERM ? ((R & ~31) + perm32(R & 31)) : R;
        voffA[i] = (unsigned)(R * K + C) * 2u; voffB[i] = (unsigned)(Rb * K + C) * 2u; }
    const size_t kstep = (size_t)(BK * 2);
    const size_t hstep = (size_t)HALF * K * 2;
    const size_t tstep = 2 * hstep;
    const unsigned ldsw = (unsigned)wid * 1024u;
    const int aoff = lds_byte(wr * 64 + fr, fq * 8), boff = lds_byte(wc * 32 + fr, fq * 8);
#define PG8_SA(b, h) (((b) * 2 + (h)) * HTB)
#define PG8_SB(b, h) ((4 + (b) * 2 + (h)) * HTB)
#define PG8_STAGE(bufoff, gbase, voff) do { _Pragma("unroll") for (int _i = 0; _i < 2; ++_i) \
        __builtin_amdgcn_global_load_lds((const unsigned*)((const char*)(gbase) + (voff)[_i]), (PG8_LAS unsigned*)(lds + (bufoff) + ldsw + _i * 8192), 16, 0, 0); } while (0)
#define PG8_LDA(dst, b, h) do { _Pragma("unroll") for (int m = 0; m < 4; ++m) _Pragma("unroll") for (int k = 0; k < 2; ++k) dst[m][k] = *(const PG8_LAS bf16x8*)(lds + PG8_SA(b, h) + aoff + m * 2048 + k * 1024); } while (0)
#define PG8_LDB(dst, b, h) do { _Pragma("unroll") for (int n = 0; n < 2; ++n) _Pragma("unroll") for (int k = 0; k < 2; ++k) dst[n][k] = *(const PG8_LAS bf16x8*)(lds + PG8_SB(b, h) + boff + n * 2048 + k * 1024); } while (0)
#define PG8_MMA(ai, bj, At, Bt) do { __builtin_amdgcn_s_setprio(1); _Pragma("unroll") for (int m = 0; m < 4; ++m) _Pragma("unroll") for (int n = 0; n < 2; ++n) _Pragma("unroll") for (int k = 0; k < 2; ++k) \
        acc[ai][bj][m][n] = __builtin_amdgcn_mfma_f32_16x16x32_bf16(Bt[n][k], At[m][k], acc[ai][bj][m][n], 0, 0, 0); __builtin_amdgcn_s_setprio(0); } while (0)
#define PG8_WAIT_V(n) asm volatile("s_waitcnt vmcnt(" #n ")" ::: "memory")
#define PG8_WAIT_L(n) asm volatile("s_waitcnt lgkmcnt(" #n ")" ::: "memory")
#define PG8_BAR __builtin_amdgcn_s_barrier()
#define PG8_SCHED __builtin_amdgcn_sched_barrier(0)
    Unit cur, nxt; int ui = 0;
    if (!S.next(0, cur)) return;
    f32x4 acc[2][2][4][2];
#pragma unroll
    for (int a = 0; a < 2; ++a)
#pragma unroll
        for (int b = 0; b < 2; ++b)
#pragma unroll
            for (int m = 0; m < 4; ++m)
#pragma unroll
                for (int n = 0; n < 2; ++n) acc[a][b][m][n] = (f32x4){0.f, 0.f, 0.f, 0.f};
    bf16x8 At[4][2], B0[2][2], B1[2][2];
    const char* cA = (const char*)g.A + (size_t)cur.pm * tstep; const char* cB = (const char*)g.Bt + (size_t)cur.pn * tstep;
    S.a_ready(cur);
    if constexpr (SP2) {
        PG8_STAGE(PG8_SB(0, 0), cB, voffB); PG8_STAGE(PG8_SB(0, 1), cB + hstep, voffB); PG8_STAGE(PG8_SA(0, 0), cA, voffA); PG8_STAGE(PG8_SA(0, 1), cA + hstep, voffA);
        if (wr == 1) PG8_BAR;
        PG8_WAIT_V(2); PG8_BAR;
        PG8_STAGE(PG8_SB(1, 0), cB + kstep, voffB); PG8_STAGE(PG8_SA(1, 0), cA + kstep, voffA); PG8_STAGE(PG8_SB(1, 1), cB + hstep + kstep, voffB);
        PG8_WAIT_V(6); PG8_BAR;
    } else {
        PG8_STAGE(PG8_SB(0, 0), cB, voffB); PG8_STAGE(PG8_SA(0, 0), cA, voffA); PG8_STAGE(PG8_SB(0, 1), cB + hstep, voffB); PG8_STAGE(PG8_SA(0, 1), cA + hstep, voffA);
        if (wr == 1) PG8_BAR;
        PG8_WAIT_V(4); PG8_BAR;
        PG8_STAGE(PG8_SB(1, 0), cB + kstep, voffB); PG8_STAGE(PG8_SA(1, 0), cA + kstep, voffA); PG8_STAGE(PG8_SB(1, 1), cB + hstep + kstep, voffB);
        PG8_WAIT_V(6); PG8_BAR;
    }
    for (;;) {
        const bool has_next = S.next(ui + 1, nxt);
        const char* nA = has_next ? (const char*)g.A + (size_t)nxt.pm * tstep : cA; const char* nB = has_next ? (const char*)g.Bt + (size_t)nxt.pn * tstep : cB;
        for (int t = 0; t < nt; t += 2) {
            const bool last = (t == nt - 2);
            const char* a1 = cA + (size_t)(t + 1) * kstep;
            const char* a2 = last ? nA : cA + (size_t)(t + 2) * kstep; const char* b2 = last ? nB : cB + (size_t)(t + 2) * kstep;
            const char* a3 = a2 + kstep; const char* b3 = b2 + kstep;
            if (last && has_next) S.a_ready(nxt);
            if constexpr (SP2) {
            PG8_LDB(B0, 0, 0); PG8_LDB(B1, 0, 1); PG8_SCHED; PG8_LDA(At, 0, 0); PG8_STAGE(PG8_SA(1, 1), a1 + hstep, voffA);
            PG8_WAIT_V(8); PG8_WAIT_L(0); PG8_BAR; PG8_MMA(0, 0, At, B0); PG8_MMA(0, 1, At, B1); PG8_BAR; PG8_SCHED;
            PG8_LDA(At, 0, 1); PG8_STAGE(PG8_SB(0, 0), b2, voffB); PG8_STAGE(PG8_SB(0, 1), b2 + hstep, voffB); PG8_STAGE(PG8_SA(0, 0), a2, voffA);
            PG8_WAIT_V(8); PG8_WAIT_L(0); PG8_BAR; PG8_MMA(1, 0, At, B0); PG8_MMA(1, 1, At, B1); PG8_BAR; PG8_SCHED;
            PG8_LDB(B0, 1, 0); PG8_LDB(B1, 1, 1); PG8_SCHED; PG8_LDA(At, 1, 0); PG8_STAGE(PG8_SA(0, 1), a2 + hstep, voffA);
            PG8_WAIT_V(8); PG8_WAIT_L(0); PG8_BAR; PG8_MMA(0, 0, At, B0); PG8_MMA(0, 1, At, B1); PG8_BAR; PG8_SCHED;
            PG8_LDA(At, 1, 1); PG8_STAGE(PG8_SB(1, 0), b3, voffB); PG8_STAGE(PG8_SB(1, 1), b3 + hstep, voffB); PG8_STAGE(PG8_SA(1, 0), a3, voffA);
            PG8_WAIT_V(8); PG8_WAIT_L(0); PG8_BAR; PG8_MMA(1, 0, At, B0); PG8_MMA(1, 1, At, B1); PG8_BAR; PG8_SCHED;
            } else {
            PG8_LDB(B0, 0, 0); PG8_SCHED; PG8_LDA(At, 0, 0); PG8_STAGE(PG8_SA(1, 1), a1 + hstep, voffA);
            PG8_WAIT_L(8); PG8_BAR; PG8_WAIT_L(0); PG8_MMA(0, 0, At, B0); PG8_BAR; PG8_SCHED;
            PG8_LDB(B1, 0, 1); PG8_STAGE(PG8_SB(0, 0), b2, voffB);
            PG8_BAR; PG8_WAIT_L(0); PG8_MMA(0, 1, At, B1); PG8_BAR;
            PG8_LDA(At, 0, 1); PG8_STAGE(PG8_SA(0, 0), a2, voffA);
            PG8_BAR; PG8_WAIT_L(0); PG8_MMA(1, 0, At, B0); PG8_BAR; PG8_SCHED;
            PG8_STAGE(PG8_SB(0, 1), b2 + hstep, voffB);
            PG8_WAIT_V(6); PG8_BAR; PG8_MMA(1, 1, At, B1); PG8_BAR;
            PG8_LDB(B0, 1, 0); PG8_SCHED; PG8_LDA(At, 1, 0); PG8_STAGE(PG8_SA(0, 1), a2 + hstep, voffA);
            PG8_WAIT_L(8); PG8_BAR; PG8_WAIT_L(0); PG8_MMA(0, 0, At, B0); PG8_BAR; PG8_SCHED;
            PG8_LDB(B1, 1, 1); PG8_STAGE(PG8_SB(1, 0), b3, voffB);
            PG8_BAR; PG8_WAIT_L(0); PG8_MMA(0, 1, At, B1); PG8_BAR;
            PG8_LDA(At, 1, 1); PG8_STAGE(PG8_SA(1, 0), a3, voffA);
            PG8_BAR; PG8_WAIT_L(0); PG8_MMA(1, 0, At, B0); PG8_BAR; PG8_SCHED;
            PG8_STAGE(PG8_SB(1, 1), b3 + hstep, voffB);
            PG8_WAIT_V(6); PG8_BAR; PG8_MMA(1, 1, At, B1); PG8_BAR;
            }
        }
        if constexpr (ALIGN_EPI) { if (wr == 0) PG8_BAR; }
        if constexpr (!Epi::AFTER_DRAIN) { E(acc, cur, wr, wc, fr, fq); S.done(cur); }
        if (!has_next) break;
#pragma unroll
        for (int a = 0; a < 2; ++a)
#pragma unroll
            for (int b = 0; b < 2; ++b)
#pragma unroll
                for (int m = 0; m < 4; ++m)
#pragma unroll
                    for (int n = 0; n < 2; ++n) acc[a][b][m][n] = (f32x4){0.f, 0.f, 0.f, 0.f};
        cur = nxt; cA = nA; cB = nB; ++ui;
        if constexpr (ALIGN_EPI) { if (wr == 1) PG8_BAR; }
    }
    PG8_WAIT_V(0);
    if constexpr (!ALIGN_EPI) { if (wr == 0) PG8_BAR; }
    PG8_BAR;
    if constexpr (Epi::AFTER_DRAIN) { E.fused(acc, cur, wr, wc, fr, fq, lds, wid, lane); S.done(cur); }
#undef PG8_SA
#undef PG8_SB
#undef PG8_STAGE
#undef PG8_LDA
#undef PG8_LDB
#undef PG8_MMA
#undef PG8_WAIT_V
#undef PG8_WAIT_L
#undef PG8_BAR
#undef PG8_SCHED
}
}
#define GAS __attribute__((address_space(1)))
#define LAS __attribute__((address_space(3)))
typedef unsigned short bf16;
typedef unsigned v4u __attribute__((ext_vector_type(4)));
typedef float f32x4 __attribute__((ext_vector_type(4)));
typedef short bf16x8 __attribute__((ext_vector_type(8)));
typedef GAS unsigned gu32;
typedef GAS unsigned long long gu64;
#define RLX_AGENT __ATOMIC_RELAXED, __HIP_MEMORY_SCOPE_AGENT
#define LDS_WAIT() asm volatile("s_waitcnt lgkmcnt(0)" ::: "memory")
#define VM_WAIT() asm volatile("s_waitcnt vmcnt(0)" ::: "memory")
__device__ __forceinline__ unsigned long long rt() { return __builtin_amdgcn_s_memrealtime(); }
__device__ __forceinline__ unsigned f2bf(float f) { unsigned u = __builtin_bit_cast(unsigned, f); return (u + 0x7fffu + ((u >> 16) & 1u)) >> 16; }
__device__ __forceinline__ unsigned pk2(float lo, float hi) { return f2bf(lo) | (f2bf(hi) << 16); }

#define XB_TMO      128
#define XB_XCNT(j)  (256  + 64 * (j))
#define XB_XSUB(j)  (1280 + 64 * (j))
#define XB_XGEN(j)  (2304 + 64 * (j))
#define XB_TOP      3328
#define XB_TOPGEN   3392
#define XCD_BAR_WORDS 3456
#define XB_SPIN_CAP (1u << 18)

__device__ __forceinline__ unsigned xb_ld(unsigned* p)              { return __hip_atomic_load(p, __ATOMIC_RELAXED, __HIP_MEMORY_SCOPE_AGENT); }
__device__ __forceinline__ unsigned xb_add(unsigned* p, unsigned v) { return __hip_atomic_fetch_add(p, v, __ATOMIC_RELAXED, __HIP_MEMORY_SCOPE_AGENT); }
__device__ __forceinline__ unsigned xb_xcc_id() { return (unsigned)__builtin_amdgcn_s_getreg((3 << 11) | 20) & 0xFu; }
#define XB_SPIN(cond, bar) do { unsigned _sp = 0; while (cond) { __builtin_amdgcn_s_sleep(1); \
    if ((++_sp & 255u) == 0u) { if (xb_ld(&(bar)[XB_TMO])) break; if (_sp > XB_SPIN_CAP) { atomicAdd(&(bar)[XB_TMO], 1u); break; } } } } while (0)

struct XcdBarrier {
    unsigned* bar; unsigned x;
    volatile LAS unsigned* st;
};

__device__ __forceinline__ XcdBarrier xcd_barrier_post(unsigned* bar, volatile LAS unsigned* st) {
    XcdBarrier b; b.bar = bar; b.x = xb_xcc_id(); b.st = st;
    if (threadIdx.x == 0) (void)xb_add(&bar[XB_XCNT(b.x)], 1u);
    return b;
}
__device__ __forceinline__ void xcd_barrier_complete(unsigned* bar, unsigned x, unsigned& nloc, unsigned& nx) {
    const unsigned G = gridDim.x * gridDim.y * gridDim.z;
    unsigned sum, cnt, mine, sp = 0u;
    for (;;) {
        sum = 0u; cnt = 0u; mine = 0u;
#pragma unroll
        for (unsigned j = 0; j < 16; ++j) { const unsigned c = xb_ld(&bar[XB_XCNT(j)]); sum += c; cnt += (c > 0u) ? 1u : 0u; mine = (j == x) ? c : mine; }
        if (sum == G) break;
        __builtin_amdgcn_s_sleep(1);
        if ((++sp & 255u) == 0u) { if (xb_ld(&bar[XB_TMO])) break; if (sp > XB_SPIN_CAP) { atomicAdd(&bar[XB_TMO], 1u); break; } }
    }
    nloc = mine > 0u ? mine : 1u; nx = cnt > 0u ? cnt : 1u;
}

__device__ __forceinline__ void xcd_barrier(const XcdBarrier& b) {
    asm volatile("s_waitcnt vmcnt(0)" ::: "memory");
    __syncthreads();
    if (threadIdx.x == 0) {
        unsigned* bar = b.bar;
        __builtin_amdgcn_s_waitcnt(0);
        unsigned nloc = b.st[0], nx = b.st[1];
        if (nloc == 0u) { xcd_barrier_complete(bar, b.x, nloc, nx); b.st[0] = nloc; b.st[1] = nx; }
        const unsigned old = xb_add(&bar[XB_XSUB(b.x)], 1u);
        const unsigned gen = old / nloc;
        if (old + 1u == (gen + 1u) * nloc) {
            __builtin_amdgcn_fence(__ATOMIC_RELEASE, "agent");
            asm volatile("s_waitcnt vmcnt(0)" ::: "memory");
            const unsigned og = xb_add(&bar[XB_TOP], 1u);
            const unsigned tg = og / nx;
            if (og + 1u == (tg + 1u) * nx) xb_add(&bar[XB_TOPGEN], 1u);
            else XB_SPIN(xb_ld(&bar[XB_TOPGEN]) == tg, bar);
            __builtin_amdgcn_fence(__ATOMIC_ACQUIRE, "agent");
            xb_add(&bar[XB_XGEN(b.x)], 1u);
            asm volatile("s_waitcnt vmcnt(0)" ::: "memory");
        } else {
            XB_SPIN(xb_ld(&bar[XB_XGEN(b.x)]) == gen, bar);
            __builtin_amdgcn_fence(__ATOMIC_ACQUIRE, "agent");
            asm volatile("s_waitcnt vmcnt(0)" ::: "memory");
        }
    }
    __syncthreads();
}
constexpr int NWAVES = 8;
constexpr int D = 1024, FF = 2816, NGU = 2 * FF, DC = 512, DL = 512, DIN = 2048, DPLE = 256;
constexpr int MP = 16384, MS = 512, M = MP + MS;
constexpr float EPS = 1e-6f;
constexpr int GEXT_ROWS = 16624 + 128 * 34, UEXT_ROWS = 16408 + 128 * 7;
constexpr size_t O_Y = 0, O_NCP = (size_t)M * D, O_NLCP = O_NCP + 8 * 30 * 512, O_NHP = O_NLCP + 8 * 3 * 512, O_NCS = O_NHP + 8 * 512, O_NLCS = O_NCS + 128 * 30 * 512, O_NHS = O_NLCS + 128 * 3 * 512, O_END = O_NHS + 128 * 512;
constexpr size_t MiB = 1u << 20;
constexpr size_t WS_CTL = 0, CTL_ZERO_BYTES = 1 * MiB;
constexpr size_t WS_WGU1 = 2 * MiB, WS_WD1 = 13 * MiB, WS_WGU2 = 19 * MiB, WS_WD2 = 30 * MiB, WS_WIN = 36 * MiB, WS_WOUT = 40 * MiB, WS_WPG = 42 * MiB, WS_WPP = 44 * MiB;
constexpr size_t WS_WAT = 45 * MiB;
constexpr size_t WS_SP8 = 45 * MiB + 512 * 1024;
constexpr size_t WS_SUM = 46 * MiB;
constexpr size_t WS_PB = 47 * MiB;
constexpr size_t WS_XA = 56 * MiB, WS_CAT = 89 * MiB, WS_RAW = 122 * MiB;
constexpr size_t WS_HID = 155 * MiB;
constexpr size_t WS_GEXT = 155 * MiB, WS_UEXT = 196 * MiB, WS_GL = 230 * MiB, WS_E = 155 * MiB, WS_END = 247 * MiB;
static_assert(WS_GEXT + (size_t)GEXT_ROWS * 2048 <= WS_UEXT && WS_UEXT + (size_t)UEXT_ROWS * 2048 <= WS_GL && WS_GL + (size_t)M * 512 * 2 <= WS_END && WS_HID + (size_t)M * FF * 2 <= WS_END, "d_ws map");
constexpr int LDS_BYTES = 147456;

__device__ __forceinline__ float wave_sum(float v) {
#pragma unroll
    for (int o = 1; o < 64; o <<= 1) v += __shfl_xor(v, o);
    return v;
}
__device__ __forceinline__ unsigned pkbf(float lo, float hi) { return pg8::cvt_pk_bf16(lo, hi); }

struct Frame {
    LAS unsigned char* lds;
    int tid, lane, wave, vcu, G;
    float* out; unsigned char* ws;
};
constexpr int BARST_OFF = 131072 + 512;
constexpr int CW_BAR = 4096;
constexpr int PTAB_OFF = 131072 + 1024;
__device__ __forceinline__ const float* inp(const Frame& F, int i) { const LAS unsigned* t = (const LAS unsigned*)(F.lds + PTAB_OFF) + 2 * i;
    const unsigned lo = __builtin_amdgcn_readfirstlane(t[0]), hi = __builtin_amdgcn_readfirstlane(t[1]); return (const float*)(((unsigned long long)hi << 32) | lo); }
enum { I_XP = 0, I_XS, I_CACHE, I_SLC, I_SLH, I_PP, I_PS, I_F1PRE, I_F1POST, I_F1GU, I_F1DN, I_MPRE, I_MPOST, I_WIN, I_CW, I_CB, I_CNG, I_LCW, I_LCB, I_LWA, I_LBA, I_LWX, I_LBX, I_LAM, I_WOUT,
       I_F2PRE, I_F2POST, I_F2GU, I_F2DN, I_PNG, I_PWG, I_PWP, I_PPOST };
__device__ __forceinline__ const float* xrow(const Frame& F, int m) { return m < MP ? inp(F, I_XP) + (size_t)m * D : inp(F, I_XS) + (size_t)(m - MP) * D; }

__device__ __forceinline__ void p0_transpose_item(const float* W, int K, int N, bf16* WT, LAS float* scr, int k0, int n0dst, int n0src, int lane) {
#pragma unroll 8
    for (int i = 0; i < 32; ++i) { const int kk = 2 * i + (lane >> 5); scr[kk * 33 + (lane & 31)] = W[(size_t)(k0 + kk) * N + n0src + (lane & 31)]; }
    LDS_WAIT(); asm volatile("" ::: "memory");
    const int c = lane & 7;
#pragma unroll
    for (int j = 0; j < 4; ++j) { const int n = (lane >> 3) + 8 * j; const LAS float* s = scr + (8 * c) * 33 + n;
        v4u o; o.x = pkbf(s[0 * 33], s[1 * 33]); o.y = pkbf(s[2 * 33], s[3 * 33]); o.z = pkbf(s[4 * 33], s[5 * 33]); o.w = pkbf(s[6 * 33], s[7 * 33]);
        *(GAS v4u*)(WT + (size_t)(n0dst + n) * K + k0 + 8 * c) = o; }
    LDS_WAIT(); asm volatile("" ::: "memory");
}
__device__ __forceinline__ int cmap_gu(int n) { const int t = n >> 8, r = n & 255; return r < 128 ? t * 128 + r : FF + t * 128 + (r - 128); }
__device__ __forceinline__ int cmap_win(int n) { const int t = n >> 8, r = n & 255; return t < 4 ? (r < 128 ? t * 128 + r : 512 + t * 128 + (r - 128)) : n; }
__device__ __forceinline__ int lru_pi(int jrow) { const int nf = jrow >> 4, q = (jrow >> 2) & 3, r = jrow & 3; return 32 * (nf >> 1) + 8 * q + 4 * (nf & 1) + r; }

__device__ __forceinline__ void p0_prologue(Frame& F) {
    LAS float* scr = (LAS float*)(F.lds + F.wave * 16384);
    const int gw = F.vcu * NWAVES + F.wave, NGW = F.G * NWAVES;
    bf16* const ws16 = (bf16*)F.ws;
    constexpr int I_GU = (D / 64) * (NGU / 32), I_DN = (FF / 64) * (D / 32), I_IN = (D / 64) * (DIN / 32), I_SQ = (D / 64) * (D / 32), I_PP_ = (DPLE / 64) * (D / 32);
    constexpr int NITEMS = 2 * I_GU + 2 * I_DN + I_IN + 2 * I_SQ + I_PP_;
    for (int it = gw; it < NITEMS; it += NGW) {
        int r = it;
        if (r < 2 * I_GU) { const int f = r >= I_GU; r -= f * I_GU; const int nb = r % (NGU / 32), kb = r / (NGU / 32);
            p0_transpose_item(f ? inp(F, I_F2GU) : inp(F, I_F1GU), D, NGU, (bf16*)(F.ws + (f ? WS_WGU2 : WS_WGU1)), scr, 64 * kb, 32 * nb, cmap_gu(32 * nb), F.lane); continue; }
        r -= 2 * I_GU;
        if (r < 2 * I_DN) { const int f = r >= I_DN; r -= f * I_DN; const int nb = r % (D / 32), kb = r / (D / 32);
            p0_transpose_item(f ? inp(F, I_F2DN) : inp(F, I_F1DN), FF, D, (bf16*)(F.ws + (f ? WS_WD2 : WS_WD1)), scr, 64 * kb, 32 * nb, 32 * nb, F.lane); continue; }
        r -= 2 * I_DN;
        if (r < I_IN) { const int nb = r % (DIN / 32), kb = r / (DIN / 32);
            p0_transpose_item(inp(F, I_WIN), D, DIN, (bf16*)(F.ws + WS_WIN), scr, 64 * kb, 32 * nb, cmap_win(32 * nb), F.lane); continue; }
        r -= I_IN;
        if (r < 2 * I_SQ) { const int f = r >= I_SQ; r -= f * I_SQ; const int nb = r % (D / 32), kb = r / (D / 32);
            p0_transpose_item(f ? inp(F, I_PWG) : inp(F, I_WOUT), D, D, (bf16*)(F.ws + (f ? WS_WPG : WS_WOUT)), scr, 64 * kb, 32 * nb, 32 * nb, F.lane); continue; }
        r -= 2 * I_SQ;
        { const int nb = r % (D / 32), kb = r / (D / 32);
            p0_transpose_item(inp(F, I_PWP), DPLE, D, (bf16*)(F.ws + WS_WPP), scr, 64 * kb, 32 * nb, 32 * nb, F.lane); }
    }
    const int gt = gw * 64 + F.lane, NGT = NGW * 64;
    for (int e = gt; e < 2 * 8 * 64 * 64; e += NGT) { const int i = e & 63, jrow = (e >> 6) & 63, h = (e >> 12) & 7, g = e >> 15;
        const float w = (g ? inp(F, I_LWX) : inp(F, I_LWA))[(h * 64 + i) * 64 + lru_pi(jrow)]; ((bf16*)(F.ws + WS_WAT))[e] = (bf16)(pkbf(w, 0.f) & 0xffffu); }
    for (int e = gt; e < 512; e += NGT) { const float l = inp(F, I_LAM)[e]; const float sp = (l < -20.f) ? -l : log1pf(expf(-l)); ((float*)(F.ws + WS_SP8))[e] = 8.0f * sp; }
    for (int e = gt; e < M * DPLE / 4; e += NGT) { const int m = e >> 6, c4 = e & 63;
        const f32x4 v = *(const f32x4*)((m < MP ? inp(F, I_PP) + (size_t)m * DPLE : inp(F, I_PS) + (size_t)(m - MP) * DPLE) + 4 * c4);
        *(unsigned long long*)(ws16 + WS_PB / 2 + (size_t)m * DPLE + 4 * c4) = (unsigned long long)pkbf(v[0], v[1]) | ((unsigned long long)pkbf(v[2], v[3]) << 32); }
    { f32x4 gn[4];
#pragma unroll
        for (int j = 0; j < 4; ++j) gn[j] = ((const f32x4*)inp(F, I_F1PRE))[F.lane + 64 * j];
        for (int m = gw; m < M; m += NGW) { const f32x4* xr = (const f32x4*)xrow(F, m) + F.lane; f32x4 v[4]; float ss = 0.f;
#pragma unroll
            for (int j = 0; j < 4; ++j) { v[j] = xr[64 * j]; ss += (v[j][0] * v[j][0] + v[j][1] * v[j][1]) + (v[j][2] * v[j][2] + v[j][3] * v[j][3]); }
            const float rs = 1.0f / sqrtf(wave_sum(ss) * (1.0f / D) + EPS);
            unsigned long long* o8 = (unsigned long long*)(ws16 + WS_XA / 2 + (size_t)m * D) + F.lane;
#pragma unroll
            for (int j = 0; j < 4; ++j) { const f32x4 y = v[j] * rs * gn[j]; o8[64 * j] = (unsigned long long)pkbf(y[0], y[1]) | ((unsigned long long)pkbf(y[2], y[3]) << 32); } } }
}

__device__ __forceinline__ void init_history(Frame& F) {
    const int gw = F.vcu * NWAVES + F.wave, NGW = F.G * NWAVES; const int gt = gw * 64 + F.lane, NGT = NGW * 64;
    { float* gext = (float*)(F.ws + WS_GEXT); float* uext = (float*)(F.ws + WS_UEXT); const f32x4 z = {0.f, 0.f, 0.f, 0.f};
        for (int e = gt; e < 8 * 30 * 128; e += NGT) { const int c4 = e & 127, rr = e >> 7, b = rr / 30, i = rr % 30; *(f32x4*)(gext + (size_t)(b * 2078 + i) * 512 + 4 * c4) = z; }
        for (int e = gt; e < 128 * 30 * 128; e += NGT) { const int c4 = e & 127, rr = e >> 7, b = rr / 30, i = rr % 30;
            *(f32x4*)(gext + (size_t)(16624 + b * 34 + i) * 512 + 4 * c4) = *(const f32x4*)(inp(F, I_CACHE) + (size_t)rr * 512 + 4 * c4); }
        for (int e = gt; e < 8 * 3 * 128; e += NGT) { const int c4 = e & 127, rr = e >> 7, b = rr / 3, i = rr % 3; *(f32x4*)(uext + (size_t)(b * 2051 + i) * 512 + 4 * c4) = z; }
        for (int e = gt; e < 128 * 3 * 128; e += NGT) { const int c4 = e & 127, rr = e >> 7, b = rr / 3, i = rr % 3;
            *(f32x4*)(uext + (size_t)(16408 + b * 7 + i) * 512 + 4 * c4) = *(const f32x4*)(inp(F, I_SLC) + (size_t)rr * 512 + 4 * c4); } }
}

template <bool FROM_INPUT, bool WRITE_XA>
__device__ __forceinline__ void row_pass(Frame& F, float alpha, const float* gpost, const float* gpre) {
    const int gw = F.vcu * NWAVES + F.wave, NGW = F.G * NWAVES;
    const bf16* raw = (const bf16*)(F.ws + WS_RAW); bf16* xa = (bf16*)(F.ws + WS_XA);
    f32x4 gp[4], gn[4];
#pragma unroll
    for (int j = 0; j < 4; ++j) { gp[j] = ((const f32x4*)gpost)[F.lane + 64 * j]; if (WRITE_XA) gn[j] = ((const f32x4*)gpre)[F.lane + 64 * j]; }
    for (int m = gw; m < M; m += NGW) {
        const f32x4* br = (const f32x4*)(FROM_INPUT ? xrow(F, m) : F.out + (size_t)m * D) + F.lane;
        f32x4* orow = (f32x4*)(F.out + (size_t)m * D) + F.lane;
        const unsigned long long* rr = (const unsigned long long*)(raw + (size_t)m * D) + F.lane;
        f32x4 v[4], b[4]; float ss = 0.f;
#pragma unroll
        for (int j = 0; j < 4; ++j) { const unsigned long long w = rr[64 * j]; v[j] = pg8::bf2_lo((unsigned)w, (unsigned)(w >> 32)); b[j] = br[64 * j];
            ss += (v[j][0] * v[j][0] + v[j][1] * v[j][1]) + (v[j][2] * v[j][2] + v[j][3] * v[j][3]); }
        const float rs = alpha / sqrtf(wave_sum(ss) * (1.0f / D) + EPS); float s2 = 0.f;
#pragma unroll
        for (int j = 0; j < 4; ++j) { b[j] = b[j] + v[j] * rs * gp[j]; orow[64 * j] = b[j]; s2 += (b[j][0] * b[j][0] + b[j][1] * b[j][1]) + (b[j][2] * b[j][2] + b[j][3] * b[j][3]); }
        if (WRITE_XA) { const float r2 = 1.0f / sqrtf(wave_sum(s2) * (1.0f / D) + EPS);
            unsigned long long* o8 = (unsigned long long*)(xa + (size_t)m * D) + F.lane;
#pragma unroll
            for (int j = 0; j < 4; ++j) { const f32x4 y = b[j] * r2 * gn[j]; o8[64 * j] = (unsigned long long)pkbf(y[0], y[1]) | ((unsigned long long)pkbf(y[2], y[3]) << 32); } }
    }
}

template <int SEG>
__device__ __forceinline__ void conv_segment(Frame& F, const float* win, int out_row0, const float (&w)[31], float cb, float cg, LAS float* red) {
    float acc[SEG];
#pragma unroll
    for (int j = 0; j < SEG; ++j) acc[j] = cb;
#pragma unroll
    for (int r = 0; r < SEG + 30; ++r) { const float v = win[(size_t)r * 512];
#pragma unroll
        for (int j = 0; j < SEG; ++j) { const int k = r - j; if (k >= 0 && k < 31) acc[j] += w[k] * v; } }
#pragma unroll
    for (int j = 0; j < SEG; ++j) { const float q = wave_sum(acc[j] * acc[j]); if (F.lane == 0) red[F.wave * 16 + j] = q; }
    __syncthreads();
    bf16* cat = (bf16*)(F.ws + WS_CAT);
#pragma unroll
    for (int j = 0; j < SEG; ++j) { float t = 0.f;
#pragma unroll
        for (int w8 = 0; w8 < NWAVES; ++w8) t += red[w8 * 16 + j];
        const float rs = 1.0f / sqrtf(t * (1.0f / DC) + EPS);
        cat[(size_t)(out_row0 + j) * D + F.tid] = (bf16)(pkbf(pg8::silu_f(acc[j] * rs * cg), 0.f) & 0xffffu); }
    __syncthreads();
}

#define DPP_SHR(old, src, d) __uint_as_float(__builtin_amdgcn_update_dpp(__float_as_uint(old), __float_as_uint(src), 0x110 + (d), 0xf, 0xf, false))
__device__ __forceinline__ float bcast15(float v, int lane) { return __shfl(v, (lane & 48) | 15); }

template <int MODE>
__device__ __forceinline__ void lru_step(Frame& F, int h, int ub, int row, float (&hc)[4][4], float (&ar)[4][4]) {
    const int fr = F.lane & 15, fq = F.lane >> 4, cb0 = 64 * h + 8 * fq;
    const float* uext = (const float*)(F.ws + WS_UEXT);
    const float* lcw = inp(F, I_LCW); const float* lcb = inp(F, I_LCB);
    asm volatile("" ::: "memory");
    f32x4 xc[2][2];
#pragma unroll
    for (int s = 0; s < 2; ++s)
#pragma unroll
        for (int hf = 0; hf < 2; ++hf) { const int ch = cb0 + 32 * s + 4 * hf; f32x4 a = *(const f32x4*)(lcb + ch);
#pragma unroll
            for (int k = 0; k < 4; ++k) a += *(const f32x4*)(lcw + k * 512 + ch) * *(const f32x4*)(uext + (size_t)(ub + k) * 512 + ch);
            xc[s][hf] = a; }
    bf16x8 bfr[2];
#pragma unroll
    for (int s = 0; s < 2; ++s) { v4u t; t.x = pkbf(xc[s][0][0], xc[s][0][1]); t.y = pkbf(xc[s][0][2], xc[s][0][3]); t.z = pkbf(xc[s][1][0], xc[s][1][1]); t.w = pkbf(xc[s][1][2], xc[s][1][3]); bfr[s] = __builtin_bit_cast(bf16x8, t); }
    const bf16* wat = (const bf16*)(F.ws + WS_WAT);
    f32x4 av[4], bv[4];
#pragma unroll
    for (int nf = 0; nf < 4; ++nf) { f32x4 cr = {0.f, 0.f, 0.f, 0.f}, ci = {0.f, 0.f, 0.f, 0.f};
        asm volatile("" ::: "memory");
#pragma unroll
        for (int s = 0; s < 2; ++s) {
            const bf16x8 wr_ = *(const bf16x8*)(wat + (size_t)((0 * 8 + h) * 64 + 16 * nf + fr) * 64 + 32 * s + 8 * fq);
            const bf16x8 wi_ = *(const bf16x8*)(wat + (size_t)((1 * 8 + h) * 64 + 16 * nf + fr) * 64 + 32 * s + 8 * fq);
            cr = __builtin_amdgcn_mfma_f32_16x16x32_bf16(wr_, bfr[s], cr, 0, 0, 0);
            ci = __builtin_amdgcn_mfma_f32_16x16x32_bf16(wi_, bfr[s], ci, 0, 0, 0); }
        const int ch = cb0 + 32 * (nf >> 1) + 4 * (nf & 1);
        const f32x4 ba = *(const f32x4*)(inp(F, I_LBA) + ch), bx = *(const f32x4*)(inp(F, I_LBX) + ch), sp = *(const f32x4*)((const float*)(F.ws + WS_SP8) + ch);
        const f32x4 x = xc[nf >> 1][nf & 1];
#pragma unroll
        for (int r = 0; r < 4; ++r) { const float rg = pg8::sigmoid_f(cr[r] + ba[r]), ig = pg8::sigmoid_f(ci[r] + bx[r]);
            const float a = __builtin_amdgcn_exp2f(-pg8::LOG2E * rg * sp[r]);
            av[nf][r] = a; bv[nf][r] = sqrtf(fmaxf(1.0f - a * a, 0.f)) * (ig * x[r]); } }
#pragma unroll
    for (int nf = 0; nf < 4; ++nf)
#pragma unroll
        for (int r = 0; r < 4; ++r) { float a = av[nf][r], b = bv[nf][r];
            if (MODE == 2) {
                { float ap = DPP_SHR(1.0f, a, 1), bp = DPP_SHR(0.f, b, 1); if ((fr & 3) < 1) { ap = 1.0f; bp = 0.f; } b = a * bp + b; a = a * ap; }
                { float ap = DPP_SHR(1.0f, a, 2), bp = DPP_SHR(0.f, b, 2); if ((fr & 3) < 2) { ap = 1.0f; bp = 0.f; } b = a * bp + b; a = a * ap; }
            } else {
                { const float ap = DPP_SHR(1.0f, a, 1), bp = DPP_SHR(0.f, b, 1); b = a * bp + b; a = a * ap; }
                { const float ap = DPP_SHR(1.0f, a, 2), bp = DPP_SHR(0.f, b, 2); b = a * bp + b; a = a * ap; }
                { const float ap = DPP_SHR(1.0f, a, 4), bp = DPP_SHR(0.f, b, 4); b = a * bp + b; a = a * ap; }
                { const float ap = DPP_SHR(1.0f, a, 8), bp = DPP_SHR(0.f, b, 8); b = a * bp + b; a = a * ap; }
            }
            av[nf][r] = a; bv[nf][r] = b; }
    if (MODE == 0) {
#pragma unroll
        for (int nf = 0; nf < 4; ++nf)
#pragma unroll
            for (int r = 0; r < 4; ++r) { const float a15 = bcast15(av[nf][r], F.lane), h15 = bcast15(bv[nf][r], F.lane); hc[nf][r] = h15 + a15 * hc[nf][r]; ar[nf][r] *= a15; }
    } else {
        const bf16* gl = (const bf16*)(F.ws + WS_GL); bf16* cat = (bf16*)(F.ws + WS_CAT);
#pragma unroll
        for (int nf = 0; nf < 4; ++nf) { const int chl = 8 * fq + 32 * (nf >> 1) + 4 * (nf & 1);
            const unsigned long long gw_ = *(const unsigned long long*)(gl + (size_t)row * 512 + 64 * h + chl); const f32x4 gg = pg8::bf2_lo((unsigned)gw_, (unsigned)(gw_ >> 32));
            f32x4 hv;
#pragma unroll
            for (int r = 0; r < 4; ++r) hv[r] = bv[nf][r] + av[nf][r] * hc[nf][r];
            *(unsigned long long*)(cat + (size_t)row * D + DC + 64 * h + chl) = (unsigned long long)pkbf(hv[0] * gg[0], hv[1] * gg[1]) | ((unsigned long long)pkbf(hv[2] * gg[2], hv[3] * gg[3]) << 32);
            if (MODE == 1) {
#pragma unroll
                for (int r = 0; r < 4; ++r) hc[nf][r] = bcast15(hv[r], F.lane);
                if ((row & 2047) == 2047) *(f32x4*)(F.out + O_NHP + (size_t)(row >> 11) * 512 + 64 * h + chl) = hv;
            } else {
                if ((fr & 3) == 3) *(f32x4*)(F.out + O_NHS + (size_t)((row - MP) >> 2) * 512 + 64 * h + chl) = hv;
            } }
    }
}

__device__ __forceinline__ void mid_pass1(Frame& F0) {
    Frame F = F0; asm volatile("" : "+v"(F.tid), "+v"(F.lane));
    LAS float* red = (LAS float*)F.lds;
    const float* gext = (const float*)(F.ws + WS_GEXT);
    float w[31];
#pragma unroll
    for (int k = 0; k < 31; ++k) w[k] = inp(F, I_CW)[k * 512 + F.tid];
    const float cb = inp(F, I_CB)[F.tid], cg = inp(F, I_CNG)[F.tid];
    for (int c = F.vcu; c < 256; c += F.G) { const int b = c >> 5, t0 = (c & 31) * 64;
#pragma unroll 1
        for (int q = 0; q < 4; ++q) conv_segment<16>(F, gext + (size_t)(b * 2078 + t0 + 16 * q) * 512 + F.tid, b * 2048 + t0 + 16 * q, w, cb, cg, red); }
    for (int sg = F.vcu; sg < 32; sg += F.G)
#pragma unroll 1
        for (int i = 0; i < 4; ++i) conv_segment<4>(F, gext + (size_t)(16624 + (4 * sg + i) * 34) * 512 + F.tid, MP + (4 * sg + i) * 4, w, cb, cg, red);
    { const int gt = (F.vcu * NWAVES + F.wave) * 64 + F.lane, NGT = F.G * NWAVES * 64; const float* uext = (const float*)(F.ws + WS_UEXT);
        for (int e = gt; e < 8 * 30 * 128; e += NGT) { const int c4 = e & 127, rr = e >> 7, b = rr / 30, i = rr % 30; *(f32x4*)(F.out + O_NCP + (size_t)rr * 512 + 4 * c4) = *(const f32x4*)(gext + (size_t)(b * 2078 + 2048 + i) * 512 + 4 * c4); }
        for (int e = gt; e < 128 * 30 * 128; e += NGT) { const int c4 = e & 127, rr = e >> 7, b = rr / 30, i = rr % 30; *(f32x4*)(F.out + O_NCS + (size_t)rr * 512 + 4 * c4) = *(const f32x4*)(gext + (size_t)(16624 + b * 34 + 4 + i) * 512 + 4 * c4); }
        for (int e = gt; e < 8 * 3 * 128; e += NGT) { const int c4 = e & 127, rr = e >> 7, b = rr / 3, i = rr % 3; *(f32x4*)(F.out + O_NLCP + (size_t)rr * 512 + 4 * c4) = *(const f32x4*)(uext + (size_t)(b * 2051 + 2048 + i) * 512 + 4 * c4); }
        for (int e = gt; e < 128 * 3 * 128; e += NGT) { const int c4 = e & 127, rr = e >> 7, b = rr / 3, i = rr % 3; *(f32x4*)(F.out + O_NLCS + (size_t)rr * 512 + 4 * c4) = *(const f32x4*)(uext + (size_t)(16408 + b * 7 + 4 + i) * 512 + 4 * c4); } }
    const int h = F.wave, fr = F.lane & 15, fq = F.lane >> 4;
    for (int c = F.vcu; c < 256; c += F.G) { const int b = c >> 5, t0 = (c & 31) * 64;
        float hc[4][4], ar[4][4];
#pragma unroll
        for (int nf = 0; nf < 4; ++nf)
#pragma unroll
            for (int r = 0; r < 4; ++r) { hc[nf][r] = 0.f; ar[nf][r] = 1.0f; }
#pragma unroll 1
        for (int st = 0; st < 4; ++st) lru_step<0>(F, h, b * 2051 + t0 + 16 * st + fr, b * 2048 + t0 + 16 * st + fr, hc, ar);
        if (fr == 0) { float* sum = (float*)(F.ws + WS_SUM) + ((size_t)c * 512 + 64 * h + 8 * fq) * 2;
#pragma unroll
            for (int nf = 0; nf < 4; ++nf) { float* p = sum + (32 * (nf >> 1) + 4 * (nf & 1)) * 2;
                *(f32x4*)p = (f32x4){ar[nf][0], hc[nf][0], ar[nf][1], hc[nf][1]}; *(f32x4*)(p + 4) = (f32x4){ar[nf][2], hc[nf][2], ar[nf][3], hc[nf][3]}; } } }
    for (int sg = F.vcu; sg < 32; sg += F.G) { const int bb = 4 * sg + (fr >> 2), t = fr & 3;
        float hc[4][4], ar[4][4];
#pragma unroll
        for (int nf = 0; nf < 4; ++nf) { const f32x4 h0 = *(const f32x4*)(inp(F, I_SLH) + (size_t)bb * 512 + 64 * h + 8 * fq + 32 * (nf >> 1) + 4 * (nf & 1));
#pragma unroll
            for (int r = 0; r < 4; ++r) { hc[nf][r] = h0[r]; ar[nf][r] = 1.0f; } }
        lru_step<2>(F, h, 16408 + bb * 7 + t, MP + bb * 4 + t, hc, ar); }
}
__device__ __forceinline__ void mid_pass2(Frame& F0) {
    Frame F = F0; asm volatile("" : "+v"(F.tid), "+v"(F.lane));
    const int h = F.wave, fr = F.lane & 15, fq = F.lane >> 4;
    for (int c = F.vcu; c < 256; c += F.G) { const int b = c >> 5, t0 = (c & 31) * 64;
        float hc[4][4], ar[4][4];
#pragma unroll
        for (int nf = 0; nf < 4; ++nf)
#pragma unroll
            for (int r = 0; r < 4; ++r) { hc[nf][r] = 0.f; ar[nf][r] = 1.0f; }
#pragma unroll 1
        for (int cc = b * 32; cc < c; ++cc) { const float* sum = (const float*)(F.ws + WS_SUM) + ((size_t)cc * 512 + 64 * h + 8 * fq) * 2;
#pragma unroll
            for (int nf = 0; nf < 4; ++nf) { const float* p = sum + (32 * (nf >> 1) + 4 * (nf & 1)) * 2; const f32x4 s0 = *(const f32x4*)p, s1 = *(const f32x4*)(p + 4);
                hc[nf][0] = s0[0] * hc[nf][0] + s0[1]; hc[nf][1] = s0[2] * hc[nf][1] + s0[3]; hc[nf][2] = s1[0] * hc[nf][2] + s1[1]; hc[nf][3] = s1[2] * hc[nf][3] + s1[3]; } }
#pragma unroll 1
        for (int st = 0; st < 4; ++st) lru_step<1>(F, h, b * 2051 + t0 + 16 * st + fr, b * 2048 + t0 + 16 * st + fr, hc, ar); }
}

struct Args { const float* in[33]; float* out; unsigned char* ws; };
__global__ void __launch_bounds__(NWAVES * 64, 2) hymba_fwd(Args args) {
    extern __shared__ __attribute__((aligned(16))) unsigned char lds_raw[];
    cg::grid_group grid = cg::this_grid();
    Frame F;
    F.lds = (LAS unsigned char*)lds_raw;
    F.tid = threadIdx.x; F.lane = F.tid & 63; F.wave = __builtin_amdgcn_readfirstlane(F.tid >> 6);
    F.G = gridDim.x; { const int bx = blockIdx.x; F.vcu = (F.G % 8 == 0) ? (bx % 8) * (F.G / 8) + bx / 8 : bx; }
    if (F.tid < 33) ((LAS unsigned long long*)(F.lds + PTAB_OFF))[F.tid] = (unsigned long long)args.in[F.tid];
    __syncthreads();
    F.out = args.out; F.ws = args.ws;
    bf16* const XA = (bf16*)(F.ws + WS_XA); bf16* const CAT = (bf16*)(F.ws + WS_CAT); bf16* const RAW = (bf16*)(F.ws + WS_RAW); bf16* const HID = (bf16*)(F.ws + WS_HID);
    volatile LAS unsigned* const bst = (volatile LAS unsigned*)(F.lds + BARST_OFF);
    if (F.tid < 2) bst[F.tid] = 0u;
    __syncthreads();
    const XcdBarrier bar = xcd_barrier_post((unsigned*)(F.ws + WS_CTL) + CW_BAR, bst);
#define GRID_BAR() xcd_barrier(bar)

    p0_prologue(F);
    grid.sync();
#pragma unroll 1
    for (int f = 0; f < 2; ++f) {
        { pg8::Gemm g{XA, (const bf16*)(F.ws + (f ? WS_WGU2 : WS_WGU1)), M, NGU, D}; pg8::StaticOrder S; S.init(M, NGU, F.G, (int)blockIdx.x);
          pg8::EpiSwiglu E{HID, FF};
          pg8::gemm_phase<pg8::EpiSwiglu, pg8::StaticOrder, true, true>(F.lds, g, S, E); }
        GRID_BAR();
        { pg8::Gemm g{HID, (const bf16*)(F.ws + (f ? WS_WD2 : WS_WD1)), M, D, FF}; pg8::StaticOrder S; S.init(M, D, F.G, (int)blockIdx.x);
          pg8::EpiRaw E{RAW, D};
          pg8::gemm_phase<pg8::EpiRaw, pg8::StaticOrder, true, true>(F.lds, g, S, E); }
        GRID_BAR();
        if (f == 0) { row_pass<true, true>(F, 0.5f, inp(F, I_F1POST), inp(F, I_MPRE)); init_history(F); }
        else        row_pass<false, true>(F, 0.5f, inp(F, I_F2POST), inp(F, I_PNG));
        GRID_BAR();
        if (f == 0) {
            { pg8::Gemm g{XA, (const bf16*)(F.ws + WS_WIN), M, DIN, D}; pg8::StaticOrder S; S.init(M, DIN, F.G, (int)blockIdx.x);
              pg8::EpiWin E{(float*)(F.ws + WS_GEXT), (float*)(F.ws + WS_UEXT), (bf16*)(F.ws + WS_GL)};
              pg8::gemm_phase<pg8::EpiWin, pg8::StaticOrder, true, true>(F.lds, g, S, E); }
            GRID_BAR();
            mid_pass1(F);
            GRID_BAR();
            mid_pass2(F);
            GRID_BAR();
            { pg8::Gemm g{CAT, (const bf16*)(F.ws + WS_WOUT), M, D, D}; pg8::StaticOrder S; S.init(M, D, F.G, (int)blockIdx.x);
              pg8::EpiRaw E{RAW, D};
              pg8::gemm_phase<pg8::EpiRaw, pg8::StaticOrder, true, true>(F.lds, g, S, E); }
            GRID_BAR();
            row_pass<false, true>(F, 1.0f, inp(F, I_MPOST), inp(F, I_F2PRE));
            GRID_BAR();
        }
    }
    { pg8::Gemm g{(const bf16*)(F.ws + WS_PB), (const bf16*)(F.ws + WS_WPP), M, D, DPLE}; pg8::StaticOrder S; S.init(M, D, F.G, (int)blockIdx.x);
      pg8::EpiRaw E{(bf16*)(F.ws + WS_E), D};
      pg8::gemm_phase<pg8::EpiRaw, pg8::StaticOrder, true, true>(F.lds, g, S, E); }
    GRID_BAR();
    { pg8::Gemm g{XA, (const bf16*)(F.ws + WS_WPG), M, D, D}; pg8::StaticOrder S; S.init(M, D, F.G, (int)blockIdx.x);
      pg8::EpiPle E{(const bf16*)(F.ws + WS_E), RAW, D};
      pg8::gemm_phase<pg8::EpiPle, pg8::StaticOrder, true, true>(F.lds, g, S, E); }
    GRID_BAR();
    row_pass<false, false>(F, 1.0f, inp(F, I_PPOST), nullptr);
}

extern "C" void kernel_launch(void* const* d_in, const int* in_sizes, int n_in, void* d_out, int out_size, void* d_ws, size_t ws_size, hipStream_t stream) {
    static int grid = 0;
    if (grid == 0) {
        if (n_in != 33 || out_size != (int)O_END || ws_size < WS_END) { fprintf(stderr, "kernel_launch: unexpected shapes (n_in %d out %d ws %zu)\n", n_in, out_size, ws_size); grid = -1; return; }
        int dev = 0, cus = 0, per_cu = 0;
        if (hipGetDevice(&dev) != hipSuccess || hipDeviceGetAttribute(&cus, hipDeviceAttributeMultiprocessorCount, dev) != hipSuccess) { grid = -1; return; }
        if (hipFuncSetAttribute((const void*)hymba_fwd, hipFuncAttributeMaxDynamicSharedMemorySize, LDS_BYTES) != hipSuccess) { fprintf(stderr, "kernel_launch: hipFuncSetAttribute failed\n"); grid = -1; return; }
        if (hipOccupancyMaxActiveBlocksPerMultiprocessor(&per_cu, (const void*)hymba_fwd, NWAVES * 64, LDS_BYTES) != hipSuccess || per_cu < 1) { fprintf(stderr, "kernel_launch: occupancy query failed (%d)\n", per_cu); (void)hipGetLastError(); per_cu = 1; }
        grid = cus;
        fprintf(stderr, "kernel_launch: cus %d per_cu %d grid %d\n", cus, per_cu, grid);
    }
    if (grid < 0) return;
    (void)hipMemsetAsync((char*)d_ws + WS_CTL, 0, CTL_ZERO_BYTES, stream);
    Args a{};
    for (int i = 0; i < 33; ++i) a.in[i] = (const float*)d_in[i];
    a.out = (float*)d_out; a.ws = (unsigned char*)d_ws;
    void* kargs[] = {&a};
    const hipError_t e = hipLaunchCooperativeKernel((const void*)hymba_fwd, dim3(grid), dim3(NWAVES * 64), kargs, LDS_BYTES, stream);
    if (e != hipSuccess) fprintf(stderr, "kernel_launch: cooperative launch failed: %s (grid %d)\n", hipGetErrorString(e), grid);
}
```

```cpp
#include <hip/hip_runtime.h>
#include <hip/hip_cooperative_groups.h>
#include <cstdio>
#include <cstdint>
namespace cg = cooperative_groups;
namespace pg8 {
#define PG8_LAS __attribute__((address_space(3)))
typedef unsigned short bf16_t;
typedef short bf16x8 __attribute__((ext_vector_type(8)));
typedef float f32x4 __attribute__((ext_vector_type(4)));
typedef unsigned u32x4 __attribute__((ext_vector_type(4)));
constexpr int BM = 256, BK = 64, HALF = 128, HTB = HALF * BK * 2  , STAGE_BYTES = 8 * HTB, NXCD = 8, WGM = 8;

__host__ __device__ __forceinline__ int lds_byte(int r, int c) { const int st = (r >> 4) * 2 + (c >> 5), rr = r & 15, cc = c & 31, ob = rr * 64 + cc * 2; return st * 1024 + (ob ^ (((ob >> 9) & 1) << 5)); }
__host__ __device__ __forceinline__ void stage_rc(int b, int& R, int& C) { const int st = b / 1024, sb = b % 1024, swz = sb ^ (((sb >> 9) & 1) << 5); R = (st >> 1) * 16 + swz / 64; C = (st & 1) * 32 + (swz % 64) / 2; }
__host__ __device__ __forceinline__ int perm32(int rho) { const int n = rho >> 4, i = rho & 15; return 8 * (i >> 2) + 4 * n + (i & 3); }

struct Unit { int pm, pn; };
struct Gemm { const bf16_t* A; const bf16_t* Bt; int M, N, K; };

struct StaticOrder {
    int nM, nN, nwg, G, c;
    __host__ __device__ void init(int M, int N, int G_, int c_) { nM = M / BM; nN = N / BM; nwg = nM * nN; G = G_; c = c_; }
    __host__ __device__ bool next(int i, Unit& u) const {
        const long L = (long)i * G + c; if (L >= nwg) return false;
        int wgid = (int)L; { const int q = nwg / NXCD, r = nwg % NXCD, xcd = wgid % NXCD, off = wgid / NXCD; wgid = (xcd < r ? xcd * (q + 1) : r * (q + 1) + (xcd - r) * q) + off; }
        const int nig = WGM * nN, gid = wgid / nig, fm = gid * WGM, gsz = (nM - fm) < WGM ? (nM - fm) : WGM;
        u.pm = fm + ((wgid % nig) % gsz); u.pn = (wgid % nig) / gsz; return true;
    }
    __device__ __forceinline__ void a_ready(const Unit&) const {}
    __device__ __forceinline__ void done(const Unit&) const {}
};
__device__ __forceinline__ unsigned cvt_pk_bf16(float lo, float hi) { unsigned r; asm volatile("v_cvt_pk_bf16_f32 %0, %1, %2" : "=v"(r) : "v"(lo), "v"(hi)); return r; }
typedef float f32x2 __attribute__((ext_vector_type(2)));
constexpr float LOG2E = 1.44269504089f;
__device__ __forceinline__ float sigmoid_f(float x) { return __builtin_amdgcn_rcpf(1.0f + __builtin_amdgcn_exp2f(-LOG2E * x)); }
__device__ __forceinline__ float silu_f(float x) { return x * sigmoid_f(x); }
__device__ __forceinline__ float gelu_tanh_f(float x) { const float z = 1.5957691216f * (x + 0.044715f * x * x * x); return x * sigmoid_f(z); }
__device__ __forceinline__ f32x4 bf2_lo(unsigned a, unsigned b) { return (f32x4){__uint_as_float(a << 16), __uint_as_float(a & 0xffff0000u), __uint_as_float(b << 16), __uint_as_float(b & 0xffff0000u)}; }

constexpr int ROWS_P = 16384, ROWS_S = 512;
__host__ __device__ __forceinline__ int gext_row(int r) { return r < ROWS_P ? (r >> 11) * 2078 + 30 + (r & 2047) : 16624 + ((r - ROWS_P) >> 2) * 34 + 30 + ((r - ROWS_P) & 3); }
__host__ __device__ __forceinline__ int uext_row(int r) { return r < ROWS_P ? (r >> 11) * 2051 + 3 + (r & 2047) : 16408 + ((r - ROWS_P) >> 2) * 7 + 3 + ((r - ROWS_P) & 3); }

struct EpiRaw {
    static constexpr bool PERM = true, AFTER_DRAIN = false;
    bf16_t* O; int ldc;
    __device__ __forceinline__ void operator()(const f32x4 (&acc)[2][2][4][2], const Unit& u, int wr, int wc, int fr, int fq) const {
        const int row0 = u.pm * BM + wr * 64 + fr, col0 = u.pn * BM + wc * 32 + 8 * fq;
#pragma unroll
        for (int ai = 0; ai < 2; ++ai)
#pragma unroll
            for (int m = 0; m < 4; ++m) { bf16_t* rowp = O + (size_t)(row0 + ai * HALF + m * 16) * ldc + col0;
#pragma unroll
                for (int bj = 0; bj < 2; ++bj) { const f32x4 v0 = acc[ai][bj][m][0], v1 = acc[ai][bj][m][1];
                    u32x4 w; w.x = cvt_pk_bf16(v0[0], v0[1]); w.y = cvt_pk_bf16(v0[2], v0[3]); w.z = cvt_pk_bf16(v1[0], v1[1]); w.w = cvt_pk_bf16(v1[2], v1[3]);
                    *(u32x4*)(rowp + bj * HALF) = w; } }
    }
};
struct EpiSwiglu {
    static constexpr bool PERM = true, AFTER_DRAIN = false;
    bf16_t* O; int ldc;
    __device__ __forceinline__ void operator()(const f32x4 (&acc)[2][2][4][2], const Unit& u, int wr, int wc, int fr, int fq) const {
        const int row0 = u.pm * BM + wr * 64 + fr, col0 = u.pn * HALF + wc * 32 + 8 * fq;
#pragma unroll
        for (int ai = 0; ai < 2; ++ai)
#pragma unroll
            for (int m = 0; m < 4; ++m) { bf16_t* rowp = O + (size_t)(row0 + ai * HALF + m * 16) * ldc + col0;
                f32x4 h[2];
#pragma unroll
                for (int n = 0; n < 2; ++n) { const f32x4 g = acc[ai][0][m][n], up = acc[ai][1][m][n];
#pragma unroll
                    for (int j = 0; j < 4; ++j) h[n][j] = silu_f(g[j]) * up[j]; }
                u32x4 w; w.x = cvt_pk_bf16(h[0][0], h[0][1]); w.y = cvt_pk_bf16(h[0][2], h[0][3]); w.z = cvt_pk_bf16(h[1][0], h[1][1]); w.w = cvt_pk_bf16(h[1][2], h[1][3]);
                *(u32x4*)rowp = w; }
    }
};
struct EpiWin {
    static constexpr bool PERM = true, AFTER_DRAIN = false;
    float* gext; float* uext; bf16_t* gl;
    __device__ __forceinline__ void operator()(const f32x4 (&acc)[2][2][4][2], const Unit& u, int wr, int wc, int fr, int fq) const {
        const int row0 = u.pm * BM + wr * 64 + fr, c0 = wc * 32 + 8 * fq;
#pragma unroll
        for (int ai = 0; ai < 2; ++ai)
#pragma unroll
            for (int m = 0; m < 4; ++m) { const int r = row0 + ai * HALF + m * 16;
                if (u.pn < 4) { float* p = gext + (size_t)gext_row(r) * 512 + u.pn * HALF + c0;
#pragma unroll
                    for (int n = 0; n < 2; ++n) { const f32x4 v = acc[ai][0][m][n], gl_ = acc[ai][1][m][n]; f32x4 o;
#pragma unroll
                        for (int j = 0; j < 4; ++j) o[j] = v[j] * sigmoid_f(gl_[j]);
                        *(f32x4*)(p + 4 * n) = o; } }
                else if (u.pn < 6) { float* p = uext + (size_t)uext_row(r) * 512 + (u.pn - 4) * BM + c0;
#pragma unroll
                    for (int bj = 0; bj < 2; ++bj)
#pragma unroll
                        for (int n = 0; n < 2; ++n) *(f32x4*)(p + bj * HALF + 4 * n) = acc[ai][bj][m][n]; }
                else { bf16_t* p = gl + (size_t)r * 512 + (u.pn - 6) * BM + c0;
#pragma unroll
                    for (int bj = 0; bj < 2; ++bj) { f32x4 a = acc[ai][bj][m][0], b = acc[ai][bj][m][1];
#pragma unroll
                        for (int j = 0; j < 4; ++j) { a[j] = gelu_tanh_f(a[j]); b[j] = gelu_tanh_f(b[j]); }
                        u32x4 w; w.x = cvt_pk_bf16(a[0], a[1]); w.y = cvt_pk_bf16(a[2], a[3]); w.z = cvt_pk_bf16(b[0], b[1]); w.w = cvt_pk_bf16(b[2], b[3]);
                        *(u32x4*)(p + bj * HALF) = w; } }
            }
    }
};
struct EpiPle {
    static constexpr bool PERM = true, AFTER_DRAIN = false;
    const bf16_t* E; bf16_t* O; int ldc;
    __device__ __forceinline__ void operator()(const f32x4 (&acc)[2][2][4][2], const Unit& u, int wr, int wc, int fr, int fq) const {
        const int row0 = u.pm * BM + wr * 64 + fr, col0 = u.pn * BM + wc * 32 + 8 * fq;
#pragma unroll
        for (int ai = 0; ai < 2; ++ai)
#pragma unroll
            for (int m = 0; m < 4; ++m) { const size_t off = (size_t)(row0 + ai * HALF + m * 16) * ldc + col0;
#pragma unroll
                for (int bj = 0; bj < 2; ++bj) { const u32x4 e = *(const u32x4*)(E + off + bj * HALF); const f32x4 e0 = bf2_lo(e.x, e.y), e1 = bf2_lo(e.z, e.w);
                    f32x4 v0 = acc[ai][bj][m][0], v1 = acc[ai][bj][m][1];
#pragma unroll
                    for (int j = 0; j < 4; ++j) { v0[j] = sigmoid_f(v0[j]) * e0[j]; v1[j] = sigmoid_f(v1[j]) * e1[j]; }
                    u32x4 w; w.x = cvt_pk_bf16(v0[0], v0[1]); w.y = cvt_pk_bf16(v0[2], v0[3]); w.z = cvt_pk_bf16(v1[0], v1[1]); w.w = cvt_pk_bf16(v1[2], v1[3]);
                    *(u32x4*)(O + off + bj * HALF) = w; } }
    }
};
template <class Epi, class Sched, bool ALIGN_EPI = false, bool SP2 = false>
__device__ __forceinline__ void gemm_phase(PG8_LAS unsigned char* lds, const Gemm g, const Sched& S, const Epi& E) {
    int tid_ = threadIdx.x; asm volatile("" : "+v"(tid_));
    const int tid = tid_, wid = __builtin_amdgcn_readfirstlane(tid >> 6), lane = tid & 63, wr = wid >> 2, wc = wid & 3, fr = lane & 15, fq = lane >> 4;
    const int K = g.K, nt = K / BK;
    unsigned voffA[2], voffB[2];
#pragma unroll
    for (int i = 0; i < 2; ++i) { int R, C; stage_rc(tid * 16 + i * 8192, R, C); const int Rb = Epi::PERM ? ((R & ~31) + perm32(R & 31)) : R;
        voffA[i] = (unsigned)(R * K + C) * 2u; voffB[i] = (unsigned)(Rb * K + C) * 2u; }
    const size_t kstep = (size_t)(BK * 2);
    const size_t hstep = (size_t)HALF * K * 2;
    const size_t tstep = 2 * hstep;
    const unsigned ldsw = (unsigned)wid * 1024u;
    const int aoff = lds_byte(wr * 64 + fr, fq * 8), boff = lds_byte(wc * 32 + fr, fq * 8);
#define PG8_SA(b, h) (((b) * 2 + (h)) * HTB)
#define PG8_SB(b, h) ((4 + (b) * 2 + (h)) * HTB)
#define PG8_STAGE(bufoff, gbase, voff) do { _Pragma("unroll") for (int _i = 0; _i < 2; ++_i) \
        __builtin_amdgcn_global_load_lds((const unsigned*)((const char*)(gbase) + (voff)[_i]), (PG8_LAS unsigned*)(lds + (bufoff) + ldsw + _i * 8192), 16, 0, 0); } while (0)
#define PG8_LDA(dst, b, h) do { _Pragma("unroll") for (int m = 0; m < 4; ++m) _Pragma("unroll") for (int k = 0; k < 2; ++k) dst[m][k] = *(const PG8_LAS bf16x8*)(lds + PG8_SA(b, h) + aoff + m * 2048 + k * 1024); } while (0)
#define PG8_LDB(dst, b, h) do { _Pragma("unroll") for (int n = 0; n < 2; ++n) _Pragma("unroll") for (int k = 0; k < 2; ++k) dst[n][k] = *(const PG8_LAS bf16x8*)(lds + PG8_SB(b, h) + boff + n * 2048 + k * 1024); } while (0)
#define PG8_MMA(ai, bj, At, Bt) do { __builtin_amdgcn_s_setprio(1); _Pragma("unroll") for (int m = 0; m < 4; ++m) _Pragma("unroll") for (int n = 0; n < 2; ++n) _Pragma("unroll") for (int k = 0; k < 2; ++k) \
        acc[ai][bj][m][n] = __builtin_amdgcn_mfma_f32_16x16x32_bf16(Bt[n][k], At[m][k], acc[ai][bj][m][n], 0, 0, 0); __builtin_amdgcn_s_setprio(0); } while (0)
#define PG8_WAIT_V(n) asm volatile("s_waitcnt vmcnt(" #n ")" ::: "memory")
#define PG8_WAIT_L(n) asm volatile("s_waitcnt lgkmcnt(" #n ")" ::: "memory")
#define PG8_BAR __builtin_amdgcn_s_barrier()
#define PG8_SCHED __builtin_amdgcn_sched_barrier(0)
    Unit cur, nxt; int ui = 0;
    if (!S.next(0, cur)) return;
    f32x4 acc[2][2][4][2];
#pragma unroll
    for (int a = 0; a < 2; ++a)
#pragma unroll
        for (int b = 0; b < 2; ++b)
#pragma unroll
            for (int m = 0; m < 4; ++m)
#pragma unroll
                for (int n = 0; n < 2; ++n) acc[a][b][m][n] = (f32x4){0.f, 0.f, 0.f, 0.f};
    bf16x8 At[4][2], B0[2][2], B1[2][2];
    const char* cA = (const char*)g.A + (size_t)cur.pm * tstep; const char* cB = (const char*)g.Bt + (size_t)cur.pn * tstep;
    S.a_ready(cur);
    if constexpr (SP2) {
        PG8_STAGE(PG8_SB(0, 0), cB, voffB); PG8_STAGE(PG8_SB(0, 1), cB + hstep, voffB); PG8_STAGE(PG8_SA(0, 0), cA, voffA); PG8_STAGE(PG8_SA(0, 1), cA + hstep, voffA);
        if (wr == 1) PG8_BAR;
        PG8_WAIT_V(2); PG8_BAR;
        PG8_STAGE(PG8_SB(1, 0), cB + kstep, voffB); PG8_STAGE(PG8_SA(1, 0), cA + kstep, voffA); PG8_STAGE(PG8_SB(1, 1), cB + hstep + kstep, voffB);
        PG8_WAIT_V(6); PG8_BAR;
    } else {
        PG8_STAGE(PG8_SB(0, 0), cB, voffB); PG8_STAGE(PG8_SA(0, 0), cA, voffA); PG8_STAGE(PG8_SB(0, 1), cB + hstep, voffB); PG8_STAGE(PG8_SA(0, 1), cA + hstep, voffA);
        if (wr == 1) PG8_BAR;
        PG8_WAIT_V(4); PG8_BAR;
        PG8_STAGE(PG8_SB(1, 0), cB + kstep, voffB); PG8_STAGE(PG8_SA(1, 0), cA + kstep, voffA); PG8_STAGE(PG8_SB(1, 1), cB + hstep + kstep, voffB);
        PG8_WAIT_V(6); PG8_BAR;
    }
    for (;;) {
        const bool has_next = S.next(ui + 1, nxt);
        const char* nA = has_next ? (const char*)g.A + (size_t)nxt.pm * tstep : cA; const char* nB = has_next ? (const char*)g.Bt + (size_t)nxt.pn * tstep : cB;
        for (int t = 0; t < nt; t += 2) {
            const bool last = (t == nt - 2);
            const char* a1 = cA + (size_t)(t + 1) * kstep;
            const char* a2 = last ? nA : cA + (size_t)(t + 2) * kstep; const char* b2 = last ? nB : cB + (size_t)(t + 2) * kstep;
            const char* a3 = a2 + kstep; const char* b3 = b2 + kstep;
            if (last && has_next) S.a_ready(nxt);
            if constexpr (SP2) {
            PG8_LDB(B0, 0, 0); PG8_LDB(B1, 0, 1); PG8_SCHED; PG8_LDA(At, 0, 0); PG8_STAGE(PG8_SA(1, 1), a1 + hstep, voffA);
            PG8_WAIT_V(8); PG8_WAIT_L(0); PG8_BAR; PG8_MMA(0, 0, At, B0); PG8_MMA(0, 1, At, B1); PG8_BAR; PG8_SCHED;
            PG8_LDA(At, 0, 1); PG8_STAGE(PG8_SB(0, 0), b2, voffB); PG8_STAGE(PG8_SB(0, 1), b2 + hstep, voffB); PG8_STAGE(PG8_SA(0, 0), a2, voffA);
            PG8_WAIT_V(8); PG8_WAIT_L(0); PG8_BAR; PG8_MMA(1, 0, At, B0); PG8_MMA(1, 1, At, B1); PG8_BAR; PG8_SCHED;
            PG8_LDB(B0, 1, 0); PG8_LDB(B1, 1, 1); PG8_SCHED; PG8_LDA(At, 1, 0); PG8_STAGE(PG8_SA(0, 1), a2 + hstep, voffA);
            PG8_WAIT_V(8); PG8_WAIT_L(0); PG8_BAR; PG8_MMA(0, 0, At, B0); PG8_MMA(0, 1, At, B1); PG8_BAR; PG8_SCHED;
            PG8_LDA(At, 1, 1); PG8_STAGE(PG8_SB(1, 0), b3, voffB); PG8_STAGE(PG8_SB(1, 1), b3 + hstep, voffB); PG8_STAGE(PG8_SA(1, 0), a3, voffA);
            PG8_WAIT_V(8); PG8_WAIT_L(0); PG8_BAR; PG8_MMA(1, 0, At, B0); PG8_MMA(1, 1, At, B1); PG8_BAR; PG8_SCHED;
            } else {
            PG8_LDB(B0, 0, 0); PG8_SCHED; PG8_LDA(At, 0, 0); PG8_STAGE(PG8_SA(1, 1), a1 + hstep, voffA);
            PG8_WAIT_L(8); PG8_BAR; PG8_WAIT_L(0); PG8_MMA(0, 0, At, B0); PG8_BAR; PG8_SCHED;
            PG8_LDB(B1, 0, 1); PG8_STAGE(PG8_SB(0, 0), b2, voffB);
            PG8_BAR; PG8_WAIT_L(0); PG8_MMA(0, 1, At, B1); PG8_BAR;
            PG8_LDA(At, 0, 1); PG8_STAGE(PG8_SA(0, 0), a2, voffA);
            PG8_BAR; PG8_WAIT_L(0); PG8_MMA(1, 0, At, B0); PG8_BAR; PG8_SCHED;
            PG8_STAGE(PG8_SB(0, 1), b2 + hstep, voffB);
            PG8_WAIT_V(6); PG8_BAR; PG8_MMA(1, 1, At, B1); PG8_BAR;
            PG8_LDB(B0, 1, 0); PG8_SCHED; PG8_LDA(At, 1, 0); PG8_STAGE(PG8_SA(0, 1), a2 + hstep, voffA);
            PG8_WAIT_L(8); PG8_BAR; PG8_WAIT_L(0); PG8_MMA(0, 0, At, B0); PG8_BAR; PG8_SCHED;
            PG8_LDB(B1, 1, 1); PG8_STAGE(PG8_SB(1, 0), b3, voffB);
            PG8_BAR; PG8_WAIT_L(0); PG8_MMA(0, 1, At, B1); PG8_BAR;
            PG8_LDA(At, 1, 1); PG8_STAGE(PG8_SA(1, 0), a3, voffA);
            PG8_BAR; PG8_WAIT_L(0); PG8_MMA(1, 0, At, B0); PG8_BAR; PG8_SCHED;
            PG8_STAGE(PG8_SB(1, 1), b3 + hstep, voffB);
            PG8_WAIT_V(6); PG8_BAR; PG8_MMA(1, 1, At, B1); PG8_BAR;
            }
        }
        if constexpr (ALIGN_EPI) { if (wr == 0) PG8_BAR; }
        if constexpr (!Epi::AFTER_DRAIN) { E(acc, cur, wr, wc, fr, fq); S.done(cur); }
        if (!has_next) break;
#pragma unroll
        for (int a = 0; a < 2; ++a)
#pragma unroll
            for (int b = 0; b < 2; ++b)
#pragma unroll
                for (int m = 0; m < 4; ++m)
#pragma unroll
                    for (int n = 0; n < 2; ++n) acc[a][b][m][n] = (f32x4){0.f, 0.f, 0.f, 0.f};
        cur = nxt; cA = nA; cB = nB; ++ui;
        if constexpr (ALIGN_EPI) { if (wr == 1) PG8_BAR; }
    }
    PG8_WAIT_V(0);
    if constexpr (!ALIGN_EPI) { if (wr == 0) PG8_BAR; }
    PG8_BAR;
    if constexpr (Epi::AFTER_DRAIN) { E.fused(acc, cur, wr, wc, fr, fq, lds, wid, lane); S.done(cur); }
#undef PG8_SA
#undef PG8_SB
#undef PG8_STAGE
#undef PG8_LDA
#undef PG8_LDB
#undef PG8_MMA
#undef PG8_WAIT_V
#undef PG8_WAIT_L
#undef PG8_BAR
#undef PG8_SCHED
}
}
#define GAS __attribute__((address_space(1)))
#define LAS __attribute__((address_space(3)))
typedef unsigned short bf16;
typedef unsigned v4u __attribute__((ext_vector_type(4)));
typedef float f32x4 __attribute__((ext_vector_type(4)));
typedef short bf16x8 __attribute__((ext_vector_type(8)));
typedef GAS unsigned gu32;
typedef GAS unsigned long long gu64;
#define RLX_AGENT __ATOMIC_RELAXED, __HIP_MEMORY_SCOPE_AGENT
#define LDS_WAIT() asm volatile("s_waitcnt lgkmcnt(0)" ::: "memory")
#define VM_WAIT() asm volatile("s_waitcnt vmcnt(0)" ::: "memory")
__device__ __forceinline__ unsigned long long rt() { return __builtin_amdgcn_s_memrealtime(); }
__device__ __forceinline__ unsigned f2bf(float f) { unsigned u = __builtin_bit_cast(unsigned, f); return (u + 0x7fffu + ((u >> 16) & 1u)) >> 16; }
__device__ __forceinline__ unsigned pk2(float lo, float hi) { return f2bf(lo) | (f2bf(hi) << 16); }

#define XB_TMO      128
#define XB_XCNT(j)  (256  + 64 * (j))
#define XB_XSUB(j)  (1280 + 64 * (j))
#define XB_XGEN(j)  (2304 + 64 * (j))
#define XB_TOP      3328
#define XB_TOPGEN   3392
#define XCD_BAR_WORDS 3456
#define XB_SPIN_CAP (1u << 18)

__device__ __forceinline__ unsigned xb_ld(unsigned* p)              { return __hip_atomic_load(p, __ATOMIC_RELAXED, __HIP_MEMORY_SCOPE_AGENT); }
__device__ __forceinline__ unsigned xb_add(unsigned* p, unsigned v) { return __hip_atomic_fetch_add(p, v, __ATOMIC_RELAXED, __HIP_MEMORY_SCOPE_AGENT); }
__device__ __forceinline__ unsigned xb_xcc_id() { return (unsigned)__builtin_amdgcn_s_getreg((3 << 11) | 20) & 0xFu; }
#define XB_SPIN(cond, bar) do { unsigned _sp = 0; while (cond) { __builtin_amdgcn_s_sleep(1); \
    if ((++_sp & 255u) == 0u) { if (xb_ld(&(bar)[XB_TMO])) break; if (_sp > XB_SPIN_CAP) { atomicAdd(&(bar)[XB_TMO], 1u); break; } } } } while (0)

struct XcdBarrier {
    unsigned* bar; unsigned x;
    volatile LAS unsigned* st;
};

__device__ __forceinline__ XcdBarrier xcd_barrier_post(unsigned* bar, volatile LAS unsigned* st) {
    XcdBarrier b; b.bar = bar; b.x = xb_xcc_id(); b.st = st;
    if (threadIdx.x == 0) (void)xb_add(&bar[XB_XCNT(b.x)], 1u);
    return b;
}
__device__ __forceinline__ void xcd_barrier_complete(unsigned* bar, unsigned x, unsigned& nloc, unsigned& nx) {
    const unsigned G = gridDim.x * gridDim.y * gridDim.z;
    unsigned sum, cnt, mine, sp = 0u;
    for (;;) {
        sum = 0u; cnt = 0u; mine = 0u;
#pragma unroll
        for (unsigned j = 0; j < 16; ++j) { const unsigned c = xb_ld(&bar[XB_XCNT(j)]); sum += c; cnt += (c > 0u) ? 1u : 0u; mine = (j == x) ? c : mine; }
        if (sum == G) break;
        __builtin_amdgcn_s_sleep(1);
        if ((++sp & 255u) == 0u) { if (xb_ld(&bar[XB_TMO])) break; if (sp > XB_SPIN_CAP) { atomicAdd(&bar[XB_TMO], 1u); break; } }
    }
    nloc = mine > 0u ? mine : 1u; nx = cnt > 0u ? cnt : 1u;
}

__device__ __forceinline__ void xcd_barrier(const XcdBarrier& b) {
    asm volatile("s_waitcnt vmcnt(0)" ::: "memory");
    __syncthreads();
    if (threadIdx.x == 0) {
        unsigned* bar = b.bar;
        __builtin_amdgcn_s_waitcnt(0);
        unsigned nloc = b.st[0], nx = b.st[1];
        if (nloc == 0u) { xcd_barrier_complete(bar, b.x, nloc, nx); b.st[0] = nloc; b.st[1] = nx; }
        const unsigned old = xb_add(&bar[XB_XSUB(b.x)], 1u);
        const unsigned gen = old / nloc;
        if (old + 1u == (gen + 1u) * nloc) {
            __builtin_amdgcn_fence(__ATOMIC_RELEASE, "agent");
            asm volatile("s_waitcnt vmcnt(0)" ::: "memory");
            const unsigned og = xb_add(&bar[XB_TOP], 1u);
            const unsigned tg = og / nx;
            if (og + 1u == (tg + 1u) * nx) xb_add(&bar[XB_TOPGEN], 1u);
            else XB_SPIN(xb_ld(&bar[XB_TOPGEN]) == tg, bar);
            __builtin_amdgcn_fence(__ATOMIC_ACQUIRE, "agent");
            xb_add(&bar[XB_XGEN(b.x)], 1u);
            asm volatile("s_waitcnt vmcnt(0)" ::: "memory");
        } else {
            XB_SPIN(xb_ld(&bar[XB_XGEN(b.x)]) == gen, bar);
            __builtin_amdgcn_fence(__ATOMIC_ACQUIRE, "agent");
            asm volatile("s_waitcnt vmcnt(0)" ::: "memory");
        }
    }
    __syncthreads();
}
constexpr int NWAVES = 8;
constexpr int D = 1024, FF = 2816, NGU = 2 * FF, DC = 512, DL = 512, DIN = 2048, DPLE = 256;
constexpr int MP = 16384, MS = 512, M = MP + MS;
constexpr float EPS = 1e-6f;
constexpr int GEXT_ROWS = 16624 + 128 * 34, UEXT_ROWS = 16408 + 128 * 7;
constexpr size_t O_Y = 0, O_NCP = (size_t)M * D, O_NLCP = O_NCP + 8 * 30 * 512, O_NHP = O_NLCP + 8 * 3 * 512, O_NCS = O_NHP + 8 * 512, O_NLCS = O_NCS + 128 * 30 * 512, O_NHS = O_NLCS + 128 * 3 * 512, O_END = O_NHS + 128 * 512;
constexpr size_t MiB = 1u << 20;
constexpr size_t WS_CTL = 0, CTL_ZERO_BYTES = 1 * MiB;
constexpr size_t WS_WGU1 = 2 * MiB, WS_WD1 = 13 * MiB, WS_WGU2 = 19 * MiB, WS_WD2 = 30 * MiB, WS_WIN = 36 * MiB, WS_WOUT = 40 * MiB, WS_WPG = 42 * MiB, WS_WPP = 44 * MiB;
constexpr size_t WS_WAT = 45 * MiB;
constexpr size_t WS_SP8 = 45 * MiB + 512 * 1024;
constexpr size_t WS_SUM = 46 * MiB;
constexpr size_t WS_PB = 47 * MiB;
constexpr size_t WS_XA = 56 * MiB, WS_CAT = 89 * MiB, WS_RAW = 122 * MiB;
constexpr size_t WS_HID = 155 * MiB;
constexpr size_t WS_GEXT = 155 * MiB, WS_UEXT = 196 * MiB, WS_GL = 230 * MiB, WS_E = 155 * MiB, WS_END = 247 * MiB;
static_assert(WS_GEXT + (size_t)GEXT_ROWS * 2048 <= WS_UEXT && WS_UEXT + (size_t)UEXT_ROWS * 2048 <= WS_GL && WS_GL + (size_t)M * 512 * 2 <= WS_END && WS_HID + (size_t)M * FF * 2 <= WS_END, "d_ws map");
constexpr int LDS_BYTES = 147456;

__device__ __forceinline__ float wave_sum(float v) {
#pragma unroll
    for (int o = 1; o < 64; o <<= 1) v += __shfl_xor(v, o);
    return v;
}
__device__ __forceinline__ unsigned pkbf(float lo, float hi) { return pg8::cvt_pk_bf16(lo, hi); }

struct Frame {
    LAS unsigned char* lds;
    int tid, lane, wave, vcu, G;
    float* out; unsigned char* ws;
};
constexpr int BARST_OFF = 131072 + 512;
constexpr int CW_BAR = 4096;
constexpr int PTAB_OFF = 131072 + 1024;
typedef const GAS float* gfp;
typedef const GAS f32x4* gf4p;
__device__ __forceinline__ gfp inp(const Frame& F, int i) { const LAS unsigned* t = (const LAS unsigned*)(F.lds + PTAB_OFF) + 2 * i;
    const unsigned lo = __builtin_amdgcn_readfirstlane(t[0]), hi = __builtin_amdgcn_readfirstlane(t[1]); return (gfp)(((unsigned long long)hi << 32) | lo); }
enum { I_XP = 0, I_XS, I_CACHE, I_SLC, I_SLH, I_PP, I_PS, I_F1PRE, I_F1POST, I_F1GU, I_F1DN, I_MPRE, I_MPOST, I_WIN, I_CW, I_CB, I_CNG, I_LCW, I_LCB, I_LWA, I_LBA, I_LWX, I_LBX, I_LAM, I_WOUT,
       I_F2PRE, I_F2POST, I_F2GU, I_F2DN, I_PNG, I_PWG, I_PWP, I_PPOST };
__device__ __forceinline__ gfp xrow(const Frame& F, int m) { return m < MP ? inp(F, I_XP) + (size_t)m * D : inp(F, I_XS) + (size_t)(m - MP) * D; }

__device__ __forceinline__ void p0_transpose_item(gfp W, int K, int N, bf16* WT, LAS float* scr, int k0, int n0dst, int n0src, int lane) {
#pragma unroll 8
    for (int i = 0; i < 32; ++i) { const int kk = 2 * i + (lane >> 5); scr[kk * 33 + (lane & 31)] = W[(size_t)(k0 + kk) * N + n0src + (lane & 31)]; }
    LDS_WAIT(); asm volatile("" ::: "memory");
    const int c = lane & 7;
#pragma unroll
    for (int j = 0; j < 4; ++j) { const int n = (lane >> 3) + 8 * j; const LAS float* s = scr + (8 * c) * 33 + n;
        v4u o; o.x = pkbf(s[0 * 33], s[1 * 33]); o.y = pkbf(s[2 * 33], s[3 * 33]); o.z = pkbf(s[4 * 33], s[5 * 33]); o.w = pkbf(s[6 * 33], s[7 * 33]);
        *(GAS v4u*)(WT + (size_t)(n0dst + n) * K + k0 + 8 * c) = o; }
    LDS_WAIT(); asm volatile("" ::: "memory");
}
__device__ __forceinline__ int cmap_gu(int n) { const int t = n >> 8, r = n & 255; return r < 128 ? t * 128 + r : FF + t * 128 + (r - 128); }
__device__ __forceinline__ int cmap_win(int n) { const int t = n >> 8, r = n & 255; return t < 4 ? (r < 128 ? t * 128 + r : 512 + t * 128 + (r - 128)) : n; }
__device__ __forceinline__ int lru_pi(int jrow) { const int nf = jrow >> 4, q = (jrow >> 2) & 3, r = jrow & 3; return 32 * (nf >> 1) + 8 * q + 4 * (nf & 1) + r; }

__device__ __forceinline__ void p0_prologue(Frame& F) {
    LAS float* scr = (LAS float*)(F.lds + F.wave * 16384);
    const int gw = F.vcu * NWAVES + F.wave, NGW = F.G * NWAVES;
    bf16* const ws16 = (bf16*)F.ws;
    constexpr int I_GU = (D / 64) * (NGU / 32), I_DN = (FF / 64) * (D / 32), I_IN = (D / 64) * (DIN / 32), I_SQ = (D / 64) * (D / 32), I_PP_ = (DPLE / 64) * (D / 32);
    constexpr int NITEMS = 2 * I_GU + 2 * I_DN + I_IN + 2 * I_SQ + I_PP_;
    for (int it = gw; it < NITEMS; it += NGW) {
        int r = it;
        if (r < 2 * I_GU) { const int f = r >= I_GU; r -= f * I_GU; const int nb = r % (NGU / 32), kb = r / (NGU / 32);
            p0_transpose_item(f ? inp(F, I_F2GU) : inp(F, I_F1GU), D, NGU, (bf16*)(F.ws + (f ? WS_WGU2 : WS_WGU1)), scr, 64 * kb, 32 * nb, cmap_gu(32 * nb), F.lane); continue; }
        r -= 2 * I_GU;
        if (r < 2 * I_DN) { const int f = r >= I_DN; r -= f * I_DN; const int nb = r % (D / 32), kb = r / (D / 32);
            p0_transpose_item(f ? inp(F, I_F2DN) : inp(F, I_F1DN), FF, D, (bf16*)(F.ws + (f ? WS_WD2 : WS_WD1)), scr, 64 * kb, 32 * nb, 32 * nb, F.lane); continue; }
        r -= 2 * I_DN;
        if (r < I_IN) { const int nb = r % (DIN / 32), kb = r / (DIN / 32);
            p0_transpose_item(inp(F, I_WIN), D, DIN, (bf16*)(F.ws + WS_WIN), scr, 64 * kb, 32 * nb, cmap_win(32 * nb), F.lane); continue; }
        r -= I_IN;
        if (r < 2 * I_SQ) { const int f = r >= I_SQ; r -= f * I_SQ; const int nb = r % (D / 32), kb = r / (D / 32);
            p0_transpose_item(f ? inp(F, I_PWG) : inp(F, I_WOUT), D, D, (bf16*)(F.ws + (f ? WS_WPG : WS_WOUT)), scr, 64 * kb, 32 * nb, 32 * nb, F.lane); continue; }
        r -= 2 * I_SQ;
        { const int nb = r % (D / 32), kb = r / (D / 32);
            p0_transpose_item(inp(F, I_PWP), DPLE, D, (bf16*)(F.ws + WS_WPP), scr, 64 * kb, 32 * nb, 32 * nb, F.lane); }
    }
    const int gt = gw * 64 + F.lane, NGT = NGW * 64;
    for (int e = gt; e < 2 * 8 * 64 * 64; e += NGT) { const int i = e & 63, jrow = (e >> 6) & 63, h = (e >> 12) & 7, g = e >> 15;
        const float w = (g ? inp(F, I_LWX) : inp(F, I_LWA))[(h * 64 + i) * 64 + lru_pi(jrow)]; ((bf16*)(F.ws + WS_WAT))[e] = (bf16)(pkbf(w, 0.f) & 0xffffu); }
    for (int e = gt; e < 512; e += NGT) { const float l = inp(F, I_LAM)[e]; const float sp = (l < -20.f) ? -l : log1pf(expf(-l)); ((float*)(F.ws + WS_SP8))[e] = 8.0f * sp; }
    for (int e = gt; e < M * DPLE / 4; e += NGT) { const int m = e >> 6, c4 = e & 63;
        const f32x4 v = *(gf4p)((m < MP ? inp(F, I_PP) + (size_t)m * DPLE : inp(F, I_PS) + (size_t)(m - MP) * DPLE) + 4 * c4);
        *(unsigned long long*)(ws16 + WS_PB / 2 + (size_t)m * DPLE + 4 * c4) = (unsigned long long)pkbf(v[0], v[1]) | ((unsigned long long)pkbf(v[2], v[3]) << 32); }
    { f32x4 gn[4];
#pragma unroll
        for (int j = 0; j < 4; ++j) gn[j] = ((gf4p)inp(F, I_F1PRE))[F.lane + 64 * j];
        for (int m = gw; m < M; m += NGW) { const gf4p xr = (gf4p)xrow(F, m) + F.lane; f32x4 v[4]; float ss = 0.f;
#pragma unroll
            for (int j = 0; j < 4; ++j) { v[j] = xr[64 * j]; ss += (v[j][0] * v[j][0] + v[j][1] * v[j][1]) + (v[j][2] * v[j][2] + v[j][3] * v[j][3]); }
            const float rs = 1.0f / sqrtf(wave_sum(ss) * (1.0f / D) + EPS);
            unsigned long long* o8 = (unsigned long long*)(ws16 + WS_XA / 2 + (size_t)m * D) + F.lane;
#pragma unroll
            for (int j = 0; j < 4; ++j) { const f32x4 y = v[j] * rs * gn[j]; o8[64 * j] = (unsigned long long)pkbf(y[0], y[1]) | ((unsigned long long)pkbf(y[2], y[3]) << 32); } } }
}

__device__ __forceinline__ void init_history(Frame& F0) {
    Frame F = F0; asm volatile("" : "+v"(F.tid), "+v"(F.lane));
    const int gw = F.vcu * NWAVES + F.wave, NGW = F.G * NWAVES; const int gt = gw * 64 + F.lane, NGT = NGW * 64;
    { float* gext = (float*)(F.ws + WS_GEXT); float* uext = (float*)(F.ws + WS_UEXT); const f32x4 z = {0.f, 0.f, 0.f, 0.f};
        for (int e = gt; e < 8 * 30 * 128; e += NGT) { const int c4 = e & 127, rr = e >> 7, b = rr / 30, i = rr % 30; *(f32x4*)(gext + (size_t)(b * 2078 + i) * 512 + 4 * c4) = z; }
        for (int e = gt; e < 128 * 30 * 128; e += NGT) { const int c4 = e & 127, rr = e >> 7, b = rr / 30, i = rr % 30;
            *(f32x4*)(gext + (size_t)(16624 + b * 34 + i) * 512 + 4 * c4) = *(gf4p)(inp(F, I_CACHE) + (size_t)rr * 512 + 4 * c4); }
        for (int e = gt; e < 8 * 3 * 128; e += NGT) { const int c4 = e & 127, rr = e >> 7, b = rr / 3, i = rr % 3; *(f32x4*)(uext + (size_t)(b * 2051 + i) * 512 + 4 * c4) = z; }
        for (int e = gt; e < 128 * 3 * 128; e += NGT) { const int c4 = e & 127, rr = e >> 7, b = rr / 3, i = rr % 3;
            *(f32x4*)(uext + (size_t)(16408 + b * 7 + i) * 512 + 4 * c4) = *(gf4p)(inp(F, I_SLC) + (size_t)rr * 512 + 4 * c4); } }
}

template <bool FROM_INPUT, bool WRITE_XA>
__device__ __forceinline__ void row_pass(Frame& F0, float alpha, gfp gpost, gfp gpre) {
    Frame F = F0; asm volatile("" : "+v"(F.tid), "+v"(F.lane));
    const int gw = F.vcu * NWAVES + F.wave, NGW = F.G * NWAVES;
    const bf16* raw = (const bf16*)(F.ws + WS_RAW); bf16* xa = (bf16*)(F.ws + WS_XA);
    f32x4 gp[4], gn[4];
#pragma unroll
    for (int j = 0; j < 4; ++j) { gp[j] = ((gf4p)gpost)[F.lane + 64 * j]; if (WRITE_XA) gn[j] = ((gf4p)gpre)[F.lane + 64 * j]; }
    for (int m = gw; m < M; m += NGW) {
        const gf4p br = (gf4p)(FROM_INPUT ? xrow(F, m) : (gfp)(F.out + (size_t)m * D)) + F.lane;
        f32x4* orow = (f32x4*)(F.out + (size_t)m * D) + F.lane;
        const unsigned long long* rr = (const unsigned long long*)(raw + (size_t)m * D) + F.lane;
        f32x4 v[4], b[4]; float ss = 0.f;
#pragma unroll
        for (int j = 0; j < 4; ++j) { const unsigned long long w = rr[64 * j]; v[j] = pg8::bf2_lo((unsigned)w, (unsigned)(w >> 32)); b[j] = br[64 * j];
            ss += (v[j][0] * v[j][0] + v[j][1] * v[j][1]) + (v[j][2] * v[j][2] + v[j][3] * v[j][3]); }
        const float rs = alpha / sqrtf(wave_sum(ss) * (1.0f / D) + EPS); float s2 = 0.f;
#pragma unroll
        for (int j = 0; j < 4; ++j) { b[j] = b[j] + v[j] * rs * gp[j]; orow[64 * j] = b[j]; s2 += (b[j][0] * b[j][0] + b[j][1] * b[j][1]) + (b[j][2] * b[j][2] + b[j][3] * b[j][3]); }
        if (WRITE_XA) { const float r2 = 1.0f / sqrtf(wave_sum(s2) * (1.0f / D) + EPS);
            unsigned long long* o8 = (unsigned long long*)(xa + (size_t)m * D) + F.lane;
#pragma unroll
            for (int j = 0; j < 4; ++j) { const f32x4 y = b[j] * r2 * gn[j]; o8[64 * j] = (unsigned long long)pkbf(y[0], y[1]) | ((unsigned long long)pkbf(y[2], y[3]) << 32); } }
    }
}

#define DPP_SHR(old, src, d) __uint_as_float(__builtin_amdgcn_update_dpp(__float_as_uint(old), __float_as_uint(src), 0x110 + (d), 0xf, 0xf, false))
__device__ __forceinline__ float bcast15(float v, int lane) { return __shfl(v, (lane & 48) | 15); }

template <int R> struct ConvRow { static __device__ __forceinline__ void run(float (&acc)[64], const float (&w)[31], const float* win) {
    const float v = win[(size_t)R * 512];
#pragma unroll
    for (int k = 0; k < 31; ++k) { if (R - k >= 0 && R - k < 64) acc[(R - k >= 0 && R - k < 64) ? R - k : 0] += w[k] * v; }
    ConvRow<R + 1>::run(acc, w, win); } };
template <> struct ConvRow<94> { static __device__ __forceinline__ void run(float (&)[64], const float (&)[31], const float*) {} };
__device__ __forceinline__ void conv64(Frame& F, const float* win, int out_row0, const float (&w)[31], float cb, float cg) {
    LAS float* red = (LAS float*)F.lds; LAS float* rsq = (LAS float*)(F.lds + 2048);
    float acc[64];
#pragma unroll
    for (int j = 0; j < 64; ++j) acc[j] = cb;
    ConvRow<0>::run(acc, w, win);
#pragma unroll
    for (int half = 0; half < 2; ++half) {
        float q[32];
#pragma unroll
        for (int j = 0; j < 32; ++j) q[j] = acc[32 * half + j] * acc[32 * half + j];
#pragma unroll
        for (int m = 32, n = 16; m >= 2; m >>= 1, n >>= 1) { const bool hi = (F.lane & m) != 0;
#pragma unroll
            for (int i = 0; i < n; ++i) { const float a = q[i], b = q[i + n]; const float keep = hi ? b : a, send = hi ? a : b; q[i] = keep + __shfl_xor(send, m); } }
        q[0] += __shfl_xor(q[0], 1);
        if ((F.lane & 1) == 0) red[(F.wave * 2 + half) * 32 + (F.lane >> 1)] = q[0];
    }
    __syncthreads();
    if (F.tid < 64) { float t = 0.f;
#pragma unroll
        for (int w8 = 0; w8 < NWAVES; ++w8) t += red[(w8 * 2 + (F.tid >> 5)) * 32 + (F.tid & 31)];
        rsq[F.tid] = 1.0f / sqrtf(t * (1.0f / DC) + EPS); }
    __syncthreads();
    bf16* cat = (bf16*)(F.ws + WS_CAT) + (size_t)out_row0 * D + F.tid;
#pragma unroll
    for (int j = 0; j < 64; ++j) cat[(size_t)j * D] = (bf16)(pkbf(pg8::silu_f(acc[j] * rsq[j] * cg), 0.f) & 0xffffu);
    __syncthreads();
}
template <int SEG>
__device__ __forceinline__ void conv_segment(Frame& F, const float* win, int out_row0, const float (&w)[31], float cb, float cg) {
    LAS float* red = (LAS float*)F.lds;
    float acc[SEG];
#pragma unroll
    for (int j = 0; j < SEG; ++j) acc[j] = cb;
#pragma unroll
    for (int r = 0; r < SEG + 30; ++r) { const float v = win[(size_t)r * 512];
#pragma unroll
        for (int j = 0; j < SEG; ++j) { const int k = r - j; if (k >= 0 && k < 31) acc[j] += w[k] * v; } }
#pragma unroll
    for (int j = 0; j < SEG; ++j) { const float q = wave_sum(acc[j] * acc[j]); if (F.lane == 0) red[F.wave * 16 + j] = q; }
    __syncthreads();
    bf16* cat = (bf16*)(F.ws + WS_CAT);
#pragma unroll
    for (int j = 0; j < SEG; ++j) { float t = 0.f;
#pragma unroll
        for (int w8 = 0; w8 < NWAVES; ++w8) t += red[w8 * 16 + j];
        const float rs = 1.0f / sqrtf(t * (1.0f / DC) + EPS);
        cat[(size_t)(out_row0 + j) * D + F.tid] = (bf16)(pkbf(pg8::silu_f(acc[j] * rs * cg), 0.f) & 0xffffu); }
    __syncthreads();
}

template <bool SEG4>
__device__ __forceinline__ void lru_gates_scan(Frame& F, int h, int ub, f32x4 (&av)[4], f32x4 (&bv)[4]) {
    const int fr = F.lane & 15, fq = F.lane >> 4, cb0 = 64 * h + 8 * fq;
    const float* uext = (const float*)(F.ws + WS_UEXT);
    const gfp lcw = inp(F, I_LCW), lcb = inp(F, I_LCB);
    f32x4 xc[2][2];
#pragma unroll
    for (int s = 0; s < 2; ++s)
#pragma unroll
        for (int hf = 0; hf < 2; ++hf) { const int ch = cb0 + 32 * s + 4 * hf; f32x4 a = *(gf4p)(lcb + ch);
#pragma unroll
            for (int k = 0; k < 4; ++k) a += *(gf4p)(lcw + k * 512 + ch) * *(const f32x4*)(uext + (size_t)(ub + k) * 512 + ch);
            xc[s][hf] = a; }
    bf16x8 bfr[2];
#pragma unroll
    for (int s = 0; s < 2; ++s) { v4u t; t.x = pkbf(xc[s][0][0], xc[s][0][1]); t.y = pkbf(xc[s][0][2], xc[s][0][3]); t.z = pkbf(xc[s][1][0], xc[s][1][1]); t.w = pkbf(xc[s][1][2], xc[s][1][3]); bfr[s] = __builtin_bit_cast(bf16x8, t); }
    const bf16* wat = (const bf16*)(F.ws + WS_WAT);
    const gfp lba = inp(F, I_LBA), lbx = inp(F, I_LBX); const float* sp8 = (const float*)(F.ws + WS_SP8);
#pragma unroll
    for (int nf = 0; nf < 4; ++nf) { f32x4 cr = {0.f, 0.f, 0.f, 0.f}, ci = {0.f, 0.f, 0.f, 0.f};
#pragma unroll
        for (int s = 0; s < 2; ++s) {
            const bf16x8 wr_ = *(const bf16x8*)(wat + (size_t)((0 * 8 + h) * 64 + 16 * nf + fr) * 64 + 32 * s + 8 * fq);
            const bf16x8 wi_ = *(const bf16x8*)(wat + (size_t)((1 * 8 + h) * 64 + 16 * nf + fr) * 64 + 32 * s + 8 * fq);
            cr = __builtin_amdgcn_mfma_f32_16x16x32_bf16(wr_, bfr[s], cr, 0, 0, 0);
            ci = __builtin_amdgcn_mfma_f32_16x16x32_bf16(wi_, bfr[s], ci, 0, 0, 0); }
        const int ch = cb0 + 32 * (nf >> 1) + 4 * (nf & 1);
        const f32x4 ba = *(gf4p)(lba + ch), bx = *(gf4p)(lbx + ch), sp = *(const f32x4*)(sp8 + ch);
        const f32x4 x = xc[nf >> 1][nf & 1];
#pragma unroll
        for (int r = 0; r < 4; ++r) { const float rg = pg8::sigmoid_f(cr[r] + ba[r]), ig = pg8::sigmoid_f(ci[r] + bx[r]);
            float a = __builtin_amdgcn_exp2f(-pg8::LOG2E * rg * sp[r]);
            float b = sqrtf(fmaxf(1.0f - a * a, 0.f)) * (ig * x[r]);
            if (SEG4) {
                { float ap = DPP_SHR(1.0f, a, 1), bp = DPP_SHR(0.f, b, 1); if ((fr & 3) < 1) { ap = 1.0f; bp = 0.f; } b = a * bp + b; a = a * ap; }
                { float ap = DPP_SHR(1.0f, a, 2), bp = DPP_SHR(0.f, b, 2); if ((fr & 3) < 2) { ap = 1.0f; bp = 0.f; } b = a * bp + b; a = a * ap; }
            } else {
                { const float ap = DPP_SHR(1.0f, a, 1), bp = DPP_SHR(0.f, b, 1); b = a * bp + b; a = a * ap; }
                { const float ap = DPP_SHR(1.0f, a, 2), bp = DPP_SHR(0.f, b, 2); b = a * bp + b; a = a * ap; }
                { const float ap = DPP_SHR(1.0f, a, 4), bp = DPP_SHR(0.f, b, 4); b = a * bp + b; a = a * ap; }
                { const float ap = DPP_SHR(1.0f, a, 8), bp = DPP_SHR(0.f, b, 8); b = a * bp + b; a = a * ap; }
            }
            av[nf][r] = a; bv[nf][r] = b; } }
}
__device__ __forceinline__ void lru_emit(Frame& F, int row, int h, int chl, const f32x4 hv) {
    const bf16* gl = (const bf16*)(F.ws + WS_GL); bf16* cat = (bf16*)(F.ws + WS_CAT);
    const unsigned long long gw_ = *(const unsigned long long*)(gl + (size_t)row * 512 + 64 * h + chl); const f32x4 gg = pg8::bf2_lo((unsigned)gw_, (unsigned)(gw_ >> 32));
    *(unsigned long long*)(cat + (size_t)row * D + DC + 64 * h + chl) = (unsigned long long)pkbf(hv[0] * gg[0], hv[1] * gg[1]) | ((unsigned long long)pkbf(hv[2] * gg[2], hv[3] * gg[3]) << 32);
}

__device__ __forceinline__ void mid_phase(Frame& F0, const XcdBarrier& bar) {
    Frame F = F0; asm volatile("" : "+v"(F.tid), "+v"(F.lane));
    const float* gext = (const float*)(F.ws + WS_GEXT);
    const int c = F.vcu, b = c >> 5, t0 = (c & 31) * 64;
    const int h = F.wave, fr = F.lane & 15, fq = F.lane >> 4;
    {
        float w[31];
#pragma unroll
        for (int k = 0; k < 31; ++k) w[k] = inp(F, I_CW)[k * 512 + F.tid];
        const float cb = inp(F, I_CB)[F.tid], cg = inp(F, I_CNG)[F.tid];
        conv64(F, gext + (size_t)(b * 2078 + t0) * 512 + F.tid, b * 2048 + t0, w, cb, cg);
        if (c < 32) {
#pragma unroll 1
            for (int i = 0; i < 4; ++i) conv_segment<4>(F, gext + (size_t)(16624 + (4 * c + i) * 34) * 512 + F.tid, MP + (4 * c + i) * 4, w, cb, cg); }
    }
    {
        const int gt = (F.vcu * NWAVES + F.wave) * 64 + F.lane, NGT = F.G * NWAVES * 64; const float* uext = (const float*)(F.ws + WS_UEXT);
        for (int e = gt; e < 8 * 30 * 128; e += NGT) { const int c4 = e & 127, rr = e >> 7, bb = rr / 30, i = rr % 30; *(f32x4*)(F.out + O_NCP + (size_t)rr * 512 + 4 * c4) = *(const f32x4*)(gext + (size_t)(bb * 2078 + 2048 + i) * 512 + 4 * c4); }
        for (int e = gt; e < 128 * 30 * 128; e += NGT) { const int c4 = e & 127, rr = e >> 7, bb = rr / 30, i = rr % 30; *(f32x4*)(F.out + O_NCS + (size_t)rr * 512 + 4 * c4) = *(const f32x4*)(gext + (size_t)(16624 + bb * 34 + 4 + i) * 512 + 4 * c4); }
        for (int e = gt; e < 8 * 3 * 128; e += NGT) { const int c4 = e & 127, rr = e >> 7, bb = rr / 3, i = rr % 3; *(f32x4*)(F.out + O_NLCP + (size_t)rr * 512 + 4 * c4) = *(const f32x4*)(uext + (size_t)(bb * 2051 + 2048 + i) * 512 + 4 * c4); }
        for (int e = gt; e < 128 * 3 * 128; e += NGT) { const int c4 = e & 127, rr = e >> 7, bb = rr / 3, i = rr % 3; *(f32x4*)(F.out + O_NLCS + (size_t)rr * 512 + 4 * c4) = *(const f32x4*)(uext + (size_t)(16408 + bb * 7 + 4 + i) * 512 + 4 * c4); }
    }
    LAS f32x4* hl = (LAS f32x4*)(F.lds + F.wave * 16384);
    f32x4 acum[4][4];
    {
#pragma unroll
        for (int st = 0; st < 4; ++st) { f32x4 av[4], bv[4];
            asm volatile("" ::: "memory");
            lru_gates_scan<false>(F, h, b * 2051 + t0 + 16 * st + fr, av, bv);
#pragma unroll
            for (int nf = 0; nf < 4; ++nf) { acum[st][nf] = av[nf]; hl[(st * 4 + nf) * 64 + F.lane] = bv[nf]; } }
        asm volatile("" ::: "memory");
#pragma unroll
        for (int nf = 0; nf < 4; ++nf) { f32x4 hc = {0.f, 0.f, 0.f, 0.f}, ar = {1.f, 1.f, 1.f, 1.f};
#pragma unroll
            for (int st = 0; st < 4; ++st) { const f32x4 hloc = hl[(st * 4 + nf) * 64 + F.lane]; hc = hloc + acum[st][nf] * hc; ar = ar * acum[st][nf]; }
            if (fr == 15) { float* p = (float*)(F.ws + WS_SUM) + ((size_t)c * 512 + 64 * h + 8 * fq + 32 * (nf >> 1) + 4 * (nf & 1)) * 2;
                *(f32x4*)p = (f32x4){ar[0], hc[0], ar[1], hc[1]}; *(f32x4*)(p + 4) = (f32x4){ar[2], hc[2], ar[3], hc[3]}; } }
    }
    if (c < 32) { const int bb = 4 * c + (fr >> 2), t = fr & 3, row = MP + bb * 4 + t;
        f32x4 av[4], bv[4];
        lru_gates_scan<true>(F, h, 16408 + bb * 7 + t, av, bv);
#pragma unroll
        for (int nf = 0; nf < 4; ++nf) { const int chl = 8 * fq + 32 * (nf >> 1) + 4 * (nf & 1);
            const f32x4 h0 = *(gf4p)(inp(F, I_SLH) + (size_t)bb * 512 + 64 * h + chl);
            const f32x4 hv = bv[nf] + av[nf] * h0;
            lru_emit(F, row, h, chl, hv);
            if (t == 3) *(f32x4*)(F.out + O_NHS + (size_t)bb * 512 + 64 * h + chl) = hv; } }
    xcd_barrier(bar);
    {
        float hc[4][4];
#pragma unroll
        for (int nf = 0; nf < 4; ++nf)
#pragma unroll
            for (int r = 0; r < 4; ++r) hc[nf][r] = 0.f;
#pragma unroll 1
        for (int cc = b * 32; cc < c; ++cc) { const float* sum = (const float*)(F.ws + WS_SUM) + ((size_t)cc * 512 + 64 * h + 8 * fq) * 2;
#pragma unroll
            for (int nf = 0; nf < 4; ++nf) { const float* p = sum + (32 * (nf >> 1) + 4 * (nf & 1)) * 2; const f32x4 s0 = *(const f32x4*)p, s1 = *(const f32x4*)(p + 4);
                hc[nf][0] = s0[0] * hc[nf][0] + s0[1]; hc[nf][1] = s0[2] * hc[nf][1] + s0[3]; hc[nf][2] = s1[0] * hc[nf][2] + s1[1]; hc[nf][3] = s1[2] * hc[nf][3] + s1[3]; } }
#pragma unroll
        for (int st = 0; st < 4; ++st) { const int row = b * 2048 + t0 + 16 * st + fr;
#pragma unroll
            for (int nf = 0; nf < 4; ++nf) { const int chl = 8 * fq + 32 * (nf >> 1) + 4 * (nf & 1);
                const f32x4 hloc = hl[(st * 4 + nf) * 64 + F.lane]; f32x4 hv;
#pragma unroll
                for (int r = 0; r < 4; ++r) hv[r] = hloc[r] + acum[st][nf][r] * hc[nf][r];
                lru_emit(F, row, h, chl, hv);
#pragma unroll
                for (int r = 0; r < 4; ++r) hc[nf][r] = bcast15(hv[r], F.lane);
                if ((row & 2047) == 2047) *(f32x4*)(F.out + O_NHP + (size_t)b * 512 + 64 * h + chl) = hv; } }
    }
    __syncthreads();
}

struct Args { const float* in[33]; float* out; unsigned char* ws; };
__global__ void __launch_bounds__(NWAVES * 64, 2) hymba_fwd(Args args) {
    extern __shared__ __attribute__((aligned(16))) unsigned char lds_raw[];
    cg::grid_group grid = cg::this_grid();
    Frame F;
    F.lds = (LAS unsigned char*)lds_raw;
    F.tid = threadIdx.x; F.lane = F.tid & 63; F.wave = __builtin_amdgcn_readfirstlane(F.tid >> 6);
    F.G = gridDim.x; { const int bx = blockIdx.x; F.vcu = (F.G % 8 == 0) ? (bx % 8) * (F.G / 8) + bx / 8 : bx; }
    if (F.tid < 33) ((LAS unsigned long long*)(F.lds + PTAB_OFF))[F.tid] = (unsigned long long)args.in[F.tid];
    __syncthreads();
    F.out = args.out; F.ws = args.ws;
    bf16* const XA = (bf16*)(F.ws + WS_XA); bf16* const CAT = (bf16*)(F.ws + WS_CAT); bf16* const RAW = (bf16*)(F.ws + WS_RAW); bf16* const HID = (bf16*)(F.ws + WS_HID);
    volatile LAS unsigned* const bst = (volatile LAS unsigned*)(F.lds + BARST_OFF);
    if (F.tid < 2) bst[F.tid] = 0u;
    __syncthreads();
    const XcdBarrier bar = xcd_barrier_post((unsigned*)(F.ws + WS_CTL) + CW_BAR, bst);
#define GRID_BAR() xcd_barrier(bar)

    p0_prologue(F);
#ifdef PROBE_PRO
    p0_prologue(F);
#endif
    grid.sync();
#pragma unroll 1
    for (int f = 0; f < 2; ++f) {
        { pg8::Gemm g{XA, (const bf16*)(F.ws + (f ? WS_WGU2 : WS_WGU1)), M, NGU, D}; pg8::StaticOrder S; S.init(M, NGU, F.G, (int)blockIdx.x);
          pg8::EpiSwiglu E{HID, FF};
          pg8::gemm_phase<pg8::EpiSwiglu, pg8::StaticOrder, true, true>(F.lds, g, S, E);
#ifdef PROBE_G1
          if (f == 0) { GRID_BAR(); pg8::gemm_phase<pg8::EpiSwiglu, pg8::StaticOrder, true, true>(F.lds, g, S, E); }
#endif
        }
        GRID_BAR();
        { pg8::Gemm g{HID, (const bf16*)(F.ws + (f ? WS_WD2 : WS_WD1)), M, D, FF}; pg8::StaticOrder S; S.init(M, D, F.G, (int)blockIdx.x);
          pg8::EpiRaw E{RAW, D};
          pg8::gemm_phase<pg8::EpiRaw, pg8::StaticOrder, true, true>(F.lds, g, S, E); }
        GRID_BAR();
        if (f == 0) { row_pass<true, true>(F, 0.5f, inp(F, I_F1POST), inp(F, I_MPRE)); init_history(F); }
        else        row_pass<false, true>(F, 0.5f, inp(F, I_F2POST), inp(F, I_PNG));
        GRID_BAR();
        if (f == 0) {
            { pg8::Gemm g{XA, (const bf16*)(F.ws + WS_WIN), M, DIN, D}; pg8::StaticOrder S; S.init(M, DIN, F.G, (int)blockIdx.x);
              pg8::EpiWin E{(float*)(F.ws + WS_GEXT), (float*)(F.ws + WS_UEXT), (bf16*)(F.ws + WS_GL)};
              pg8::gemm_phase<pg8::EpiWin, pg8::StaticOrder, true, true>(F.lds, g, S, E); }
            GRID_BAR();
            mid_phase(F, bar);
            GRID_BAR();
#ifdef PROBE_MID
            mid_phase(F, bar);
            GRID_BAR();
#endif
            { pg8::Gemm g{CAT, (const bf16*)(F.ws + WS_WOUT), M, D, D}; pg8::StaticOrder S; S.init(M, D, F.G, (int)blockIdx.x);
              pg8::EpiRaw E{RAW, D};
              pg8::gemm_phase<pg8::EpiRaw, pg8::StaticOrder, true, true>(F.lds, g, S, E); }
            GRID_BAR();
            row_pass<false, true>(F, 1.0f, inp(F, I_MPOST), inp(F, I_F2PRE));
            GRID_BAR();
        }
    }
    { pg8::Gemm g{(const bf16*)(F.ws + WS_PB), (const bf16*)(F.ws + WS_WPP), M, D, DPLE}; pg8::StaticOrder S; S.init(M, D, F.G, (int)blockIdx.x);
      pg8::EpiRaw E{(bf16*)(F.ws + WS_E), D};
      pg8::gemm_phase<pg8::EpiRaw, pg8::StaticOrder, true, true>(F.lds, g, S, E); }
    GRID_BAR();
    { pg8::Gemm g{XA, (const bf16*)(F.ws + WS_WPG), M, D, D}; pg8::StaticOrder S; S.init(M, D, F.G, (int)blockIdx.x);
      pg8::EpiPle E{(const bf16*)(F.ws + WS_E), RAW, D};
      pg8::gemm_phase<pg8::EpiPle, pg8::StaticOrder, true, true>(F.lds, g, S, E); }
    GRID_BAR();
    row_pass<false, false>(F, 1.0f, inp(F, I_PPOST), nullptr);
}

extern "C" void kernel_launch(void* const* d_in, const int* in_sizes, int n_in, void* d_out, int out_size, void* d_ws, size_t ws_size, hipStream_t stream) {
    static int grid = 0;
    if (grid == 0) {
        if (n_in != 33 || out_size != (int)O_END || ws_size < WS_END) { fprintf(stderr, "kernel_launch: unexpected shapes (n_in %d out %d ws %zu)\n", n_in, out_size, ws_size); grid = -1; return; }
        int dev = 0, cus = 0, per_cu = 0;
        if (hipGetDevice(&dev) != hipSuccess || hipDeviceGetAttribute(&cus, hipDeviceAttributeMultiprocessorCount, dev) != hipSuccess) { grid = -1; return; }
        if (hipFuncSetAttribute((const void*)hymba_fwd, hipFuncAttributeMaxDynamicSharedMemorySize, LDS_BYTES) != hipSuccess) { fprintf(stderr, "kernel_launch: hipFuncSetAttribute failed\n"); grid = -1; return; }
        if (hipOccupancyMaxActiveBlocksPerMultiprocessor(&per_cu, (const void*)hymba_fwd, NWAVES * 64, LDS_BYTES) != hipSuccess || per_cu < 1) { fprintf(stderr, "kernel_launch: occupancy query failed (%d)\n", per_cu); (void)hipGetLastError(); per_cu = 1; }
        if (cus < 256) { fprintf(stderr, "kernel_launch: needs 256 CUs, device has %d\n", cus); grid = -1; return; }
        grid = 256;
        fprintf(stderr, "kernel_launch: cus %d per_cu %d grid %d\n", cus, per_cu, grid);
    }
    if (grid < 0) return;
    (void)hipMemsetAsync((char*)d_ws + WS_CTL, 0, CTL_ZERO_BYTES, stream);
    Args a{};
    for (int i = 0; i < 33; ++i) a.in[i] = (const float*)d_in[i];
    a.out = (float*)d_out; a.ws = (unsigned char*)d_ws;
    void* kargs[] = {&a};
    const hipError_t e = hipLaunchCooperativeKernel((const void*)hymba_fwd, dim3(grid), dim3(NWAVES * 64), kargs, LDS_BYTES, stream);
    if (e != hipSuccess) fprintf(stderr, "kernel_launch: cooperative launch failed: %s (grid %d)\n", hipGetErrorString(e), grid);
}
```
